# Optimizing an MI355X kernel written in HIP

```python
import jax, jax.numpy as jnp
from jax import lax
import numpy as np

D_MODEL = 1024
BATCH = 4
SEQ = 4096
DEPTH = 2

N_A_LAYERS = DEPTH // 2
N_B_LAYERS = DEPTH - N_A_LAYERS
CHUNK = 128
A_EXPAND = 2
A_WIDTH = A_EXPAND * D_MODEL
A_GROUPS = 16
A_GROUP_DIM = A_WIDTH // A_GROUPS
HEAD_DIM = 64
N_Q_HEADS = D_MODEL // HEAD_DIM
N_KV_HEADS = max(1, N_Q_HEADS // 8)
Q_PER_KV = N_Q_HEADS // N_KV_HEADS
B_WIDTH = N_Q_HEADS * HEAD_DIM
KV_WIDTH = N_KV_HEADS * HEAD_DIM
WINDOW = 128
ROPE_THETA = 10000.0
EPS = 1e-5

kernel_name = "yoco_gmlp_swa_sink_hybrid"


def rms_norm(x, g):
    xf = x.astype(jnp.float32)
    y = xf * lax.rsqrt(jnp.mean(xf * xf, axis=-1, keepdims=True) + EPS) * g.astype(jnp.float32)
    return y.astype(x.dtype)


def layer_norm(x, g, b):
    xf = x.astype(jnp.float32)
    mu = jnp.mean(xf, axis=-1, keepdims=True)
    xc = xf - mu
    var = jnp.mean(xc * xc, axis=-1, keepdims=True)
    y = xc * lax.rsqrt(var + EPS) * g.astype(jnp.float32) + b.astype(jnp.float32)
    return y.astype(x.dtype)


def rotary(x, pos):
    dh = x.shape[-1]
    inv_freq = ROPE_THETA ** (-jnp.arange(0, dh, 2, dtype=jnp.float32) / dh)
    ang = pos[:, None] * inv_freq[None, :]
    cos = jnp.cos(ang)[None, :, None, :].astype(x.dtype)
    sin = jnp.sin(ang)[None, :, None, :].astype(x.dtype)
    x1, x2 = jnp.split(x, 2, axis=-1)
    return jnp.concatenate([x1 * cos - x2 * sin, x2 * cos + x1 * sin], axis=-1)


def band(t):
    b, s, h, d = t.shape
    blk = t.reshape(b, s // CHUNK, CHUNK, h, d)
    prev = jnp.concatenate([jnp.zeros_like(blk[:, :1]), blk[:, :-1]], axis=1)
    return jnp.concatenate([prev, blk], axis=2)


def gmlp_mixer(h, w_in, ln_g, ln_b, ws, bs, w_out):
    b, s, _ = h.shape
    nc = s // CHUNK
    z = h @ w_in
    u, v, g = jnp.split(z, 3, axis=-1)
    v = layer_norm(v, ln_g, ln_b)
    v = v.reshape(b, nc, CHUNK, A_GROUPS, A_GROUP_DIM)
    causal = jnp.tril(jnp.ones((CHUNK, CHUNK), dtype=bool))
    wsm = jnp.where(causal[None], ws, jnp.zeros_like(ws)).astype(v.dtype)
    sv = jnp.einsum('gts,bcsgd->bctgd', wsm, v) + bs.T[:, :, None].astype(v.dtype)
    sv = sv.reshape(b, s, A_WIDTH)
    y = u * sv * jax.nn.silu(g)
    return y @ w_out


def swa_mixer(h, k_band, v_band, pos, w_in, b_q, sinks, w_out):
    b, s, _ = h.shape
    nb = s // CHUNK
    z = h @ w_in
    q, g = jnp.split(z, 2, axis=-1)
    q = (q + b_q).reshape(b, s, N_Q_HEADS, HEAD_DIM)
    q = rotary(q, pos).reshape(b, nb, CHUNK, N_KV_HEADS, Q_PER_KV, HEAD_DIM)
    scores = jnp.einsum('bnqhrd,bnkhd->bnhrqk', q, k_band).astype(jnp.float32) * (HEAD_DIM ** -0.5)
    qi = jnp.arange(CHUNK)[:, None]
    kj = jnp.arange(2 * CHUNK)[None, :]
    rel = kj - CHUNK - qi
    in_window = (rel <= 0) & (rel > -WINDOW)
    key_valid = (jnp.arange(nb)[:, None] * CHUNK + jnp.arange(2 * CHUNK)[None, :] - CHUNK) >= 0
    mask = in_window[None] & key_valid[:, None, :]
    scores = jnp.where(mask[None, :, None, None], scores, -jnp.inf)
    sink = sinks.astype(jnp.float32).reshape(N_KV_HEADS, Q_PER_KV)[None, None, :, :, None, None]
    m = jnp.maximum(jnp.max(scores, axis=-1, keepdims=True), sink)
    p = jnp.exp(scores - m)
    denom = jnp.sum(p, axis=-1, keepdims=True) + jnp.exp(sink - m)
    p = (p / denom).astype(v_band.dtype)
    o = jnp.einsum('bnhrqk,bnkhd->bnqhrd', p, v_band).reshape(b, s, B_WIDTH)
    y = o * jax.nn.silu(g)
    return y @ w_out


def setup_inputs(seed: int = 0) -> dict:
    key = jax.random.key(seed)
    ks = jax.random.split(key, 20)
    f32 = jnp.float32
    nrm = lambda k, shp, sc: jax.random.normal(k, shp, f32) * sc
    return {
        "x": nrm(ks[0], (BATCH, SEQ, D_MODEL), 1.0),
        "a_norm_g": 1.0 + nrm(ks[1], (N_A_LAYERS, D_MODEL), 0.02),
        "a_w_in": nrm(ks[2], (N_A_LAYERS, D_MODEL, 3 * A_WIDTH), D_MODEL ** -0.5),
        "a_ln_g": 1.0 + nrm(ks[3], (N_A_LAYERS, A_WIDTH), 0.02),
        "a_ln_b": nrm(ks[4], (N_A_LAYERS, A_WIDTH), 0.02),
        "a_ws": nrm(ks[5], (N_A_LAYERS, A_GROUPS, CHUNK, CHUNK), 0.5 * CHUNK ** -0.5),
        "a_bs": 1.0 + nrm(ks[6], (N_A_LAYERS, A_GROUPS, CHUNK), 0.02),
        "a_w_out": nrm(ks[7], (N_A_LAYERS, A_WIDTH, D_MODEL), 0.5 * A_WIDTH ** -0.5),
        "kv_norm_g": 1.0 + nrm(ks[8], (D_MODEL,), 0.02),
        "w_kv": nrm(ks[9], (D_MODEL, 2 * KV_WIDTH), D_MODEL ** -0.5),
        "b_kv": nrm(ks[10], (2 * KV_WIDTH,), 0.02),
        "b_norm_g": 1.0 + nrm(ks[11], (N_B_LAYERS, D_MODEL), 0.02),
        "b_w_in": nrm(ks[12], (N_B_LAYERS, D_MODEL, 2 * B_WIDTH), D_MODEL ** -0.5),
        "b_bq": nrm(ks[13], (N_B_LAYERS, B_WIDTH), 0.02),
        "b_sinks": nrm(ks[14], (N_B_LAYERS, N_Q_HEADS), 1.0),
        "b_w_out": nrm(ks[15], (N_B_LAYERS, B_WIDTH, D_MODEL), B_WIDTH ** -0.5),
        "final_norm_g": 1.0 + nrm(ks[16], (D_MODEL,), 0.02),
    }


def reference(x, a_norm_g, a_w_in, a_ln_g, a_ln_b, a_ws, a_bs, a_w_out, kv_norm_g, w_kv, b_kv,
              b_norm_g, b_w_in, b_bq, b_sinks, b_w_out, final_norm_g):
    b, s, _ = x.shape
    pos = jnp.arange(s, dtype=jnp.float32)
    h = x
    k_band = None
    v_band = None
    for l in range(DEPTH):
        if l < N_A_LAYERS:
            i = l
            h = h + gmlp_mixer(rms_norm(h, a_norm_g[i]), a_w_in[i], a_ln_g[i], a_ln_b[i],
                               a_ws[i], a_bs[i], a_w_out[i])
        else:
            if l == N_A_LAYERS:
                kv = rms_norm(h, kv_norm_g) @ w_kv + b_kv
                k, v = jnp.split(kv, 2, axis=-1)
                k = rotary(k.reshape(b, s, N_KV_HEADS, HEAD_DIM), pos)
                v = v.reshape(b, s, N_KV_HEADS, HEAD_DIM)
                k_band = band(k)
                v_band = band(v)
            i = l - N_A_LAYERS
            h = h + swa_mixer(rms_norm(h, b_norm_g[i]), k_band, v_band, pos,
                              b_w_in[i], b_bq[i], b_sinks[i], b_w_out[i])
    return rms_norm(h, final_norm_g)
```

```cpp
#include <hip/hip_runtime.h>
#include <hip/hip_cooperative_groups.h>
#include <cstdio>
#include <cstdint>
#include <cmath>
namespace cg = cooperative_groups;
namespace pg8 {
#define PG8_LAS __attribute__((address_space(3)))
typedef unsigned short bf16_t;
typedef short bf16x8 __attribute__((ext_vector_type(8)));
typedef float f32x4 __attribute__((ext_vector_type(4)));
typedef unsigned u32x4 __attribute__((ext_vector_type(4)));
constexpr int BM = 256, BK = 64, HALF = 128, HTB = HALF * BK * 2  , STAGE_BYTES = 8 * HTB, NXCD = 8, WGM = 8;

__host__ __device__ __forceinline__ int lds_byte(int r, int c) { const int st = (r >> 4) * 2 + (c >> 5), rr = r & 15, cc = c & 31, ob = rr * 64 + cc * 2; return st * 1024 + (ob ^ (((ob >> 9) & 1) << 5)); }
__host__ __device__ __forceinline__ void stage_rc(int b, int& R, int& C) { const int st = b / 1024, sb = b % 1024, swz = sb ^ (((sb >> 9) & 1) << 5); R = (st >> 1) * 16 + swz / 64; C = (st & 1) * 32 + (swz % 64) / 2; }
__host__ __device__ __forceinline__ int perm32(int rho) { const int n = rho >> 4, i = rho & 15; return 8 * (i >> 2) + 4 * n + (i & 3); }

struct Unit { int pm, pn; };
struct Gemm { const bf16_t* A; const bf16_t* Bt; int M, N, K; };

struct StaticOrder {
    int nM, nN, nwg, G, c;
    __host__ __device__ void init(int M, int N, int G_, int c_) { nM = M / BM; nN = N / BM; nwg = nM * nN; G = G_; c = c_; }
    __host__ __device__ bool next(int i, Unit& u) const {
        const long L = (long)i * G + c; if (L >= nwg) return false;
        int wgid = (int)L; { const int q = nwg / NXCD, r = nwg % NXCD, xcd = wgid % NXCD, off = wgid / NXCD; wgid = (xcd < r ? xcd * (q + 1) : r * (q + 1) + (xcd - r) * q) + off; }
        const int nig = WGM * nN, gid = wgid / nig, fm = gid * WGM, gsz = (nM - fm) < WGM ? (nM - fm) : WGM;
        u.pm = fm + ((wgid % nig) % gsz); u.pn = (wgid % nig) / gsz; return true;
    }
    __device__ __forceinline__ void a_ready(const Unit&) const {}
    __device__ __forceinline__ void done(const Unit&) const {}
};

__device__ __forceinline__ unsigned cvt_pk_bf16(float lo, float hi) { unsigned r; asm volatile("v_cvt_pk_bf16_f32 %0, %1, %2" : "=v"(r) : "v"(lo), "v"(hi)); return r; }
typedef float f32x2 __attribute__((ext_vector_type(2)));
typedef unsigned u32x2 __attribute__((ext_vector_type(2)));
__device__ __forceinline__ unsigned pkbf(float lo, float hi) { unsigned r; asm("v_cvt_pk_bf16_f32 %0, %1, %2" : "=v"(r) : "v"(lo), "v"(hi)); return r; }
constexpr float RMS_EPS = 1e-5f;

struct EpiZ {
    static constexpr bool PERM = true, AFTER_DRAIN = false;
    bf16_t* Z; float* st;
    __device__ __forceinline__ void operator()(const f32x4 (&acc)[2][2][4][2], const Unit& u, int wr, int wc, int fr, int fq) const {
        const int row0 = u.pm * BM + wr * 64 + fr, col0 = u.pn * BM + wc * 32 + 8 * fq;
        const bool isv = (u.pn >= 8 && u.pn < 16);
#pragma unroll
        for (int ai = 0; ai < 2; ++ai)
#pragma unroll
            for (int m = 0; m < 4; ++m) { const int row = row0 + ai * HALF + m * 16; bf16_t* rowp = Z + (size_t)row * 6144 + col0;
                float s = 0.f, q = 0.f;
#pragma unroll
                for (int bj = 0; bj < 2; ++bj) { const f32x4 v0 = acc[ai][bj][m][0], v1 = acc[ai][bj][m][1];
                    u32x4 w; w.x = pkbf(v0[0], v0[1]); w.y = pkbf(v0[2], v0[3]); w.z = pkbf(v1[0], v1[1]); w.w = pkbf(v1[2], v1[3]);
                    *(u32x4*)(rowp + bj * HALF) = w;
                    s += (v0[0] + v0[1]) + (v0[2] + v0[3]) + (v1[0] + v1[1]) + (v1[2] + v1[3]);
                    q += (v0[0] * v0[0] + v0[1] * v0[1]) + (v0[2] * v0[2] + v0[3] * v0[3]) + (v1[0] * v1[0] + v1[1] * v1[1]) + (v1[2] * v1[2] + v1[3] * v1[3]); }
                if (isv) { s += __shfl_xor(s, 16); s += __shfl_xor(s, 32); q += __shfl_xor(q, 16); q += __shfl_xor(q, 32);
                    if (fq == 0) { f32x2 o; o.x = s; o.y = q; *(f32x2*)(st + ((size_t)row * 32 + (u.pn - 8) * 4 + wc) * 2) = o; } }
            }
    }
};

struct EpiRes {
    static constexpr bool PERM = false, AFTER_DRAIN = false;
    const float* base; float* out; bf16_t* outb; float* st;
    __device__ __forceinline__ void operator()(const f32x4 (&acc)[2][2][4][2], const Unit& u, int wr, int wc, int fr, int fq) const {
        const int row0 = u.pm * BM + wr * 64 + fr, col0 = u.pn * BM + wc * 32 + 4 * fq;
#pragma unroll
        for (int ai = 0; ai < 2; ++ai)
#pragma unroll
            for (int m = 0; m < 4; ++m) { const int row = row0 + ai * HALF + m * 16; const size_t off = (size_t)row * 1024 + col0; float q = 0.f;
#pragma unroll
                for (int bj = 0; bj < 2; ++bj)
#pragma unroll
                    for (int n = 0; n < 2; ++n) { const f32x4 b = *(const f32x4*)(base + off + bj * HALF + n * 16); const f32x4 h = b + acc[ai][bj][m][n];
                        *(f32x4*)(out + off + bj * HALF + n * 16) = h;
                        if (outb) { u32x2 w; w.x = pkbf(h[0], h[1]); w.y = pkbf(h[2], h[3]); *(u32x2*)(outb + off + bj * HALF + n * 16) = w; }
                        q += (h[0] * h[0] + h[1] * h[1]) + (h[2] * h[2] + h[3] * h[3]); }
                q += __shfl_xor(q, 16); q += __shfl_xor(q, 32);
                if (fq == 0) st[(size_t)row * 16 + u.pn * 4 + wc] = q;
            }
    }
};

struct EpiQKV {
    static constexpr bool PERM = false, AFTER_DRAIN = false;
    const float* st2; const float* rot; const float* bq; const float* bkv; bf16_t* Q; bf16_t* Gt; bf16_t* Kb; bf16_t* Vb;
    __device__ __forceinline__ void operator()(const f32x4 (&acc)[2][2][4][2], const Unit& u, int wr, int wc, int fr, int fq) const {
        const int row0 = u.pm * BM + wr * 64 + fr;
        float rs[2][4];
#pragma unroll
        for (int ai = 0; ai < 2; ++ai)
#pragma unroll
            for (int m = 0; m < 4; ++m) { const f32x4* p = (const f32x4*)(st2 + (size_t)(row0 + ai * HALF + m * 16) * 16); const f32x4 a = (p[0] + p[1]) + (p[2] + p[3]);
                rs[ai][m] = 1.0f / sqrtf(((a[0] + a[1]) + (a[2] + a[3])) * (1.0f / 1024.0f) + RMS_EPS); }
        if (u.pn >= 4 && u.pn < 8) {
            const int col0 = (u.pn - 4) * BM + wc * 32 + 4 * fq;
#pragma unroll
            for (int ai = 0; ai < 2; ++ai)
#pragma unroll
                for (int m = 0; m < 4; ++m) { const int row = row0 + ai * HALF + m * 16; const float r = rs[ai][m];
#pragma unroll
                    for (int bj = 0; bj < 2; ++bj)
#pragma unroll
                        for (int n = 0; n < 2; ++n) { const f32x4 v = acc[ai][bj][m][n] * r; u32x2 w; w.x = pkbf(v[0], v[1]); w.y = pkbf(v[2], v[3]);
                            *(u32x2*)(Gt + (size_t)row * 1024 + col0 + bj * HALF + n * 16) = w; } }
            return;
        }
        const bool isq = (u.pn < 4);
        const int i0 = (wc & 1) * 16 + 4 * fq;
#pragma unroll
        for (int bj = 0; bj < 2; ++bj) {
            if (!isq && bj == 1) {
                const int col0 = wc * 32 + 4 * fq;
#pragma unroll
                for (int n = 0; n < 2; ++n) { const f32x4 bv = *(const f32x4*)(bkv + 128 + col0 + n * 16);
#pragma unroll
                    for (int ai = 0; ai < 2; ++ai)
#pragma unroll
                        for (int m = 0; m < 4; ++m) { const int row = row0 + ai * HALF + m * 16; const f32x4 v = acc[ai][1][m][n] * rs[ai][m] + bv;
                            u32x2 w; w.x = pkbf(v[0], v[1]); w.y = pkbf(v[2], v[3]); *(u32x2*)(Vb + (size_t)row * 128 + col0 + n * 16) = w; } }
            } else {
                const int head = isq ? (u.pn * 4 + bj * 2 + (wc >> 1)) : (wc >> 1);
                const float* bias = (isq ? bq : bkv) + head * 64 + i0;
                const f32x4 b1 = *(const f32x4*)(bias), b2 = *(const f32x4*)(bias + 32);
                const float sc = isq ? (0.125f * 1.4426950408889634f) : 1.0f;
                bf16_t* dstb = isq ? (Q + head * 64 + i0) : (Kb + head * 64 + i0); const int ldo = isq ? 1024 : 128;
#pragma unroll
                for (int ai = 0; ai < 2; ++ai)
#pragma unroll
                    for (int m = 0; m < 4; ++m) { const int row = row0 + ai * HALF + m * 16; const int pos = row & 4095;
                        const f32x4* rp = (const f32x4*)(rot + ((size_t)pos * 32 + i0) * 2); const f32x4 cs0 = rp[0], cs1 = rp[1];
                        const f32x4 x1 = acc[ai][bj][m][0] * rs[ai][m] + b1, x2 = acc[ai][bj][m][1] * rs[ai][m] + b2;
                        const float c[4] = {cs0[0], cs0[2], cs1[0], cs1[2]}, s[4] = {cs0[1], cs0[3], cs1[1], cs1[3]};
                        float o1[4], o2[4];
#pragma unroll
                        for (int j = 0; j < 4; ++j) { o1[j] = (x1[j] * c[j] - x2[j] * s[j]) * sc; o2[j] = (x2[j] * c[j] + x1[j] * s[j]) * sc; }
                        u32x2 w1, w2; w1.x = pkbf(o1[0], o1[1]); w1.y = pkbf(o1[2], o1[3]); w2.x = pkbf(o2[0], o2[1]); w2.y = pkbf(o2[2], o2[3]);
                        bf16_t* d = dstb + (size_t)row * ldo; *(u32x2*)d = w1; *(u32x2*)(d + 32) = w2; }
            }
        }
    }
};

template <class Epi, class Sched, bool ALIGN_EPI = false, bool SP2 = false>
__device__ __forceinline__ void gemm_phase(PG8_LAS unsigned char* lds, const Gemm g, const Sched& S, const Epi& E) {
    const int tid = threadIdx.x, wid = __builtin_amdgcn_readfirstlane(tid >> 6), lane = tid & 63, wr = wid >> 2, wc = wid & 3, fr = lane & 15, fq = lane >> 4;
    const int K = g.K, nt = K / BK;
    unsigned voffA[2], voffB[2];
#pragma unroll
    for (int i = 0; i < 2; ++i) { int R, C; stage_rc(tid * 16 + i * 8192, R, C); const int Rb = Epi::PERM ? ((R & ~31) + perm32(R & 31)) : R;
        voffA[i] = (unsigned)(R * K + C) * 2u; voffB[i] = (unsigned)(Rb * K + C) * 2u; }
    const size_t kstep = (size_t)(BK * 2);
    const size_t hstep = (size_t)HALF * K * 2;
    const size_t tstep = 2 * hstep;
    const unsigned ldsw = (unsigned)wid * 1024u;
    const int aoff = lds_byte(wr * 64 + fr, fq * 8), boff = lds_byte(wc * 32 + fr, fq * 8);
#define PG8_SA(b, h) (((b) * 2 + (h)) * HTB)
#define PG8_SB(b, h) ((4 + (b) * 2 + (h)) * HTB)
#define PG8_STAGE(bufoff, gbase, voff) do { _Pragma("unroll") for (int _i = 0; _i < 2; ++_i) \
        __builtin_amdgcn_global_load_lds((const unsigned*)((const char*)(gbase) + (voff)[_i]), (PG8_LAS unsigned*)(lds + (bufoff) + ldsw + _i * 8192), 16, 0, 0); } while (0)
#define PG8_LDA(dst, b, h) do { _Pragma("unroll") for (int m = 0; m < 4; ++m) _Pragma("unroll") for (int k = 0; k < 2; ++k) dst[m][k] = *(const PG8_LAS bf16x8*)(lds + PG8_SA(b, h) + aoff + m * 2048 + k * 1024); } while (0)
#define PG8_LDB(dst, b, h) do { _Pragma("unroll") for (int n = 0; n < 2; ++n) _Pragma("unroll") for (int k = 0; k < 2; ++k) dst[n][k] = *(const PG8_LAS bf16x8*)(lds + PG8_SB(b, h) + boff + n * 2048 + k * 1024); } while (0)
#define PG8_MMA(ai, bj, At, Bt) do { __builtin_amdgcn_s_setprio(1); _Pragma("unroll") for (int m = 0; m < 4; ++m) _Pragma("unroll") for (int n = 0; n < 2; ++n) _Pragma("unroll") for (int k = 0; k < 2; ++k) \
        acc[ai][bj][m][n] = __builtin_amdgcn_mfma_f32_16x16x32_bf16(Bt[n][k], At[m][k], acc[ai][bj][m][n], 0, 0, 0); __builtin_amdgcn_s_setprio(0); } while (0)
#define PG8_WAIT_V(n) asm volatile("s_waitcnt vmcnt(" #n ")" ::: "memory")
#define PG8_WAIT_L(n) asm volatile("s_waitcnt lgkmcnt(" #n ")" ::: "memory")
#define PG8_BAR __builtin_amdgcn_s_barrier()
#define PG8_SCHED __builtin_amdgcn_sched_barrier(0)
    Unit cur, nxt; int ui = 0;
    if (!S.next(0, cur)) return;
    f32x4 acc[2][2][4][2];
#pragma unroll
    for (int a = 0; a < 2; ++a)
#pragma unroll
        for (int b = 0; b < 2; ++b)
#pragma unroll
            for (int m = 0; m < 4; ++m)
#pragma unroll
                for (int n = 0; n < 2; ++n) acc[a][b][m][n] = (f32x4){0.f, 0.f, 0.f, 0.f};
    bf16x8 At[4][2], B0[2][2], B1[2][2];
    const char* cA = (const char*)g.A + (size_t)cur.pm * tstep; const char* cB = (const char*)g.Bt + (size_t)cur.pn * tstep;
    S.a_ready(cur);
    if constexpr (SP2) {
        PG8_STAGE(PG8_SB(0, 0), cB, voffB); PG8_STAGE(PG8_SB(0, 1), cB + hstep, voffB); PG8_STAGE(PG8_SA(0, 0), cA, voffA); PG8_STAGE(PG8_SA(0, 1), cA + hstep, voffA);
        if (wr == 1) PG8_BAR;
        PG8_WAIT_V(2); PG8_BAR;
        PG8_STAGE(PG8_SB(1, 0), cB + kstep, voffB); PG8_STAGE(PG8_SA(1, 0), cA + kstep, voffA); PG8_STAGE(PG8_SB(1, 1), cB + hstep + kstep, voffB);
        PG8_WAIT_V(6); PG8_BAR;
    } else {
        PG8_STAGE(PG8_SB(0, 0), cB, voffB); PG8_STAGE(PG8_SA(0, 0), cA, voffA); PG8_STAGE(PG8_SB(0, 1), cB + hstep, voffB); PG8_STAGE(PG8_SA(0, 1), cA + hstep, voffA);
        if (wr == 1) PG8_BAR;
        PG8_WAIT_V(4); PG8_BAR;
        PG8_STAGE(PG8_SB(1, 0), cB + kstep, voffB); PG8_STAGE(PG8_SA(1, 0), cA + kstep, voffA); PG8_STAGE(PG8_SB(1, 1), cB + hstep + kstep, voffB);
        PG8_WAIT_V(6); PG8_BAR;
    }
    for (;;) {
        const bool has_next = S.next(ui + 1, nxt);
        const char* nA = has_next ? (const char*)g.A + (size_t)nxt.pm * tstep : cA; const char* nB = has_next ? (const char*)g.Bt + (size_t)nxt.pn * tstep : cB;
        for (int t = 0; t < nt; t += 2) {
            const bool last = (t == nt - 2);
            const char* a1 = cA + (size_t)(t + 1) * kstep;
            const char* a2 = last ? nA : cA + (size_t)(t + 2) * kstep; const char* b2 = last ? nB : cB + (size_t)(t + 2) * kstep;
            const char* a3 = a2 + kstep; const char* b3 = b2 + kstep;
            if (last && has_next) S.a_ready(nxt);
            if constexpr (SP2) {
            PG8_LDB(B0, 0, 0); PG8_LDB(B1, 0, 1); PG8_SCHED; PG8_LDA(At, 0, 0); PG8_STAGE(PG8_SA(1, 1), a1 + hstep, voffA);
            PG8_WAIT_V(8); PG8_WAIT_L(0); PG8_BAR; PG8_MMA(0, 0, At, B0); PG8_MMA(0, 1, At, B1); PG8_BAR; PG8_SCHED;
            PG8_LDA(At, 0, 1); PG8_STAGE(PG8_SB(0, 0), b2, voffB); PG8_STAGE(PG8_SB(0, 1), b2 + hstep, voffB); PG8_STAGE(PG8_SA(0, 0), a2, voffA);
            PG8_WAIT_V(8); PG8_WAIT_L(0); PG8_BAR; PG8_MMA(1, 0, At, B0); PG8_MMA(1, 1, At, B1); PG8_BAR; PG8_SCHED;
            PG8_LDB(B0, 1, 0); PG8_LDB(B1, 1, 1); PG8_SCHED; PG8_LDA(At, 1, 0); PG8_STAGE(PG8_SA(0, 1), a2 + hstep, voffA);
            PG8_WAIT_V(8); PG8_WAIT_L(0); PG8_BAR; PG8_MMA(0, 0, At, B0); PG8_MMA(0, 1, At, B1); PG8_BAR; PG8_SCHED;
            PG8_LDA(At, 1, 1); PG8_STAGE(PG8_SB(1, 0), b3, voffB); PG8_STAGE(PG8_SB(1, 1), b3 + hstep, voffB); PG8_STAGE(PG8_SA(1, 0), a3, voffA);
            PG8_WAIT_V(8); PG8_WAIT_L(0); PG8_BAR; PG8_MMA(1, 0, At, B0); PG8_MMA(1, 1, At, B1); PG8_BAR; PG8_SCHED;
            } else {
            PG8_LDB(B0, 0, 0); PG8_SCHED; PG8_LDA(At, 0, 0); PG8_STAGE(PG8_SA(1, 1), a1 + hstep, voffA);
            PG8_WAIT_L(8); PG8_BAR; PG8_WAIT_L(0); PG8_MMA(0, 0, At, B0); PG8_BAR; PG8_SCHED;
            PG8_LDB(B1, 0, 1); PG8_STAGE(PG8_SB(0, 0), b2, voffB);
            PG8_BAR; PG8_WAIT_L(0); PG8_MMA(0, 1, At, B1); PG8_BAR;
            PG8_LDA(At, 0, 1); PG8_STAGE(PG8_SA(0, 0), a2, voffA);
            PG8_BAR; PG8_WAIT_L(0); PG8_MMA(1, 0, At, B0); PG8_BAR; PG8_SCHED;
            PG8_STAGE(PG8_SB(0, 1), b2 + hstep, voffB);
            PG8_WAIT_V(6); PG8_BAR; PG8_MMA(1, 1, At, B1); PG8_BAR;
            PG8_LDB(B0, 1, 0); PG8_SCHED; PG8_LDA(At, 1, 0); PG8_STAGE(PG8_SA(0, 1), a2 + hstep, voffA);
            PG8_WAIT_L(8); PG8_BAR; PG8_WAIT_L(0); PG8_MMA(0, 0, At, B0); PG8_BAR; PG8_SCHED;
            PG8_LDB(B1, 1, 1); PG8_STAGE(PG8_SB(1, 0), b3, voffB);
            PG8_BAR; PG8_WAIT_L(0); PG8_MMA(0, 1, At, B1); PG8_BAR;
            PG8_LDA(At, 1, 1); PG8_STAGE(PG8_SA(1, 0), a3, voffA);
            PG8_BAR; PG8_WAIT_L(0); PG8_MMA(1, 0, At, B0); PG8_BAR; PG8_SCHED;
            PG8_STAGE(PG8_SB(1, 1), b3 + hstep, voffB);
            PG8_WAIT_V(6); PG8_BAR; PG8_MMA(1, 1, At, B1); PG8_BAR;
            }
        }
        if constexpr (ALIGN_EPI) { if (wr == 0) PG8_BAR; }
        if constexpr (!Epi::AFTER_DRAIN) { E(acc, cur, wr, wc, fr, fq); S.done(cur); }
        if (!has_next) break;
#pragma unroll
        for (int a = 0; a < 2; ++a)
#pragma unroll
            for (int b = 0; b < 2; ++b)
#pragma unroll
                for (int m = 0; m < 4; ++m)
#pragma unroll
                    for (int n = 0; n < 2; ++n) acc[a][b][m][n] = (f32x4){0.f, 0.f, 0.f, 0.f};
        cur = nxt; cA = nA; cB = nB; ++ui;
        if constexpr (ALIGN_EPI) { if (wr == 1) PG8_BAR; }
    }
    PG8_WAIT_V(0);
    if constexpr (!ALIGN_EPI) { if (wr == 0) PG8_BAR; }
    PG8_BAR;
    if constexpr (Epi::AFTER_DRAIN) { E.fused(acc, cur, wr, wc, fr, fq, lds, wid, lane); S.done(cur); }
#undef PG8_SA
#undef PG8_SB
#undef PG8_STAGE
#undef PG8_LDA
#undef PG8_LDB
#undef PG8_MMA
#undef PG8_WAIT_V
#undef PG8_WAIT_L
#undef PG8_BAR
#undef PG8_SCHED
}
}

constexpr int M = 16384, DM = 1024, SEQ = 4096, AW = 2048, NZ = 6144, NQKV = 2304;
constexpr float EPS = 1e-5f, LOG2E = 1.4426950408889634f;
constexpr size_t MiB = 1u << 20;
constexpr size_t WS_WIN = 1 * MiB;
constexpr size_t WS_WOA = 13 * MiB;
constexpr size_t WS_WCAT = 17 * MiB;
constexpr size_t WS_WOB = 22 * MiB;
constexpr size_t WS_WSM = 24 * MiB;
constexpr size_t WS_ROT = 25 * MiB;
constexpr size_t WS_ST1 = 26 * MiB;
constexpr size_t WS_ST2 = 30 * MiB;
constexpr size_t WS_ST3 = 31 * MiB;
constexpr size_t WS_Z = 32 * MiB;
constexpr size_t WS_XN = 224 * MiB;
constexpr size_t WS_H = 32 * MiB;
constexpr size_t WS_HB = 96 * MiB;
constexpr size_t WS_Q = 128 * MiB;
constexpr size_t WS_G = 160 * MiB;
constexpr size_t WS_K = 192 * MiB;
constexpr size_t WS_V = 196 * MiB;
constexpr size_t WS_Y2 = 224 * MiB;
constexpr size_t WS_END = 256 * MiB;
constexpr int LDS_BYTES = 131072 + 1024;

#define LAS __attribute__((address_space(3)))
typedef unsigned short bf16;
typedef float f32x2 __attribute__((ext_vector_type(2)));
typedef float f32x4 __attribute__((ext_vector_type(4)));
typedef float f32x16 __attribute__((ext_vector_type(16)));
typedef unsigned u32x2 __attribute__((ext_vector_type(2)));
typedef unsigned u32x4 __attribute__((ext_vector_type(4)));
typedef short bf16x8 __attribute__((ext_vector_type(8)));
typedef short s16x4 __attribute__((ext_vector_type(4)));

__device__ __forceinline__ unsigned pk2(float lo, float hi) { return pg8::pkbf(lo, hi); }
__device__ __forceinline__ float bflo(unsigned w) { return __uint_as_float(w << 16); }
__device__ __forceinline__ float bfhi(unsigned w) { return __uint_as_float(w & 0xffff0000u); }
__device__ __forceinline__ float silu(float x) { return x * __builtin_amdgcn_rcpf(1.0f + __builtin_amdgcn_exp2f(-x * LOG2E)); }
__device__ __forceinline__ float wave_sum(float v) {
#pragma unroll
    for (int o = 1; o < 64; o <<= 1) v += __shfl_xor(v, o);
    return v;
}

__device__ __forceinline__ int rot_phys(int L) {
    const int hit = (L >> 6) & 3, d = L & 63, n = d >> 5, i = d & 31, wlo = i >> 4, i16 = i & 15;
    const int bj = hit >> 1, wc = (hit & 1) * 2 + wlo;
    return 128 * bj + 32 * wc + 16 * n + i16;
}
__device__ __forceinline__ int wrow(int mode, int n) {
    if (mode == 2) return n < 1024 ? ((n & ~255) + rot_phys(n & 255)) : n;
    if (mode == 3) return n < 128 ? (2048 + rot_phys(n)) : (2048 + n);
    return n;
}
__device__ __forceinline__ void p0_transpose_item(const float* W, int K, int N, bf16* WT, const float* gain, int mode, LAS float* scr, int item, int lane) {
    const int nblk = N / 32, kb = item / nblk, nb = item % nblk, k0 = 64 * kb, n0 = 32 * nb;
#pragma unroll 8
    for (int i = 0; i < 32; ++i) { const int kk = 2 * i + (lane >> 5); float w = W[(size_t)(k0 + kk) * N + n0 + (lane & 31)]; if (gain) w *= gain[k0 + kk]; scr[kk * 33 + (lane & 31)] = w; }
    asm volatile("s_waitcnt lgkmcnt(0)" ::: "memory");
    const int c = lane & 7;
#pragma unroll
    for (int j = 0; j < 4; ++j) { const int n = (lane >> 3) + 8 * j; const LAS float* s = scr + (8 * c) * 33 + n;
        u32x4 o; o.x = pk2(s[0 * 33], s[1 * 33]); o.y = pk2(s[2 * 33], s[3 * 33]); o.z = pk2(s[4 * 33], s[5 * 33]); o.w = pk2(s[6 * 33], s[7 * 33]);
        *(u32x4*)(WT + (size_t)wrow(mode, n0 + n) * K + k0 + 8 * c) = o; }
    asm volatile("s_waitcnt lgkmcnt(0)" ::: "memory");
}

struct Args { const float* in[17]; float* out; unsigned char* ws; float inv_freq[32]; };

__device__ __forceinline__ void p0_prologue(const Args& a, LAS unsigned char* lds, int bid, int G) {
    const int tid = threadIdx.x, lane = tid & 63, wave = tid >> 6;
    LAS float* scr = (LAS float*)(lds + wave * 16384);
    const int gw = bid * 8 + wave, NGW = G * 8;
    unsigned char* ws = a.ws;
    constexpr int I0 = (1024 / 64) * (6144 / 32), I1 = (2048 / 64) * (1024 / 32), I2 = (1024 / 64) * (2048 / 32), I3 = (1024 / 64) * (256 / 32), I4 = (1024 / 64) * (1024 / 32);
    constexpr int NITEMS = I0 + I1 + I2 + I3 + I4;
    for (int it = gw; it < NITEMS; it += NGW) {
        int r = it;
        if (r < I0) { p0_transpose_item(a.in[2], 1024, 6144, (bf16*)(ws + WS_WIN), a.in[1], 0, scr, r, lane); continue; } r -= I0;
        if (r < I1) { p0_transpose_item(a.in[7], 2048, 1024, (bf16*)(ws + WS_WOA), nullptr, 1, scr, r, lane); continue; } r -= I1;
        if (r < I2) { p0_transpose_item(a.in[12], 1024, 2048, (bf16*)(ws + WS_WCAT), a.in[11], 2, scr, r, lane); continue; } r -= I2;
        if (r < I3) { p0_transpose_item(a.in[9], 1024, 256, (bf16*)(ws + WS_WCAT), a.in[8], 3, scr, r, lane); continue; } r -= I3;
        p0_transpose_item(a.in[15], 1024, 1024, (bf16*)(ws + WS_WOB), nullptr, 4, scr, r, lane);
    }
    const float* x = a.in[0]; bf16* XN = (bf16*)(ws + WS_XN);
    for (int m = gw; m < M; m += NGW) {
        const f32x4* xr = (const f32x4*)(x + (size_t)m * DM) + lane;
        f32x4 v[4]; float s2 = 0.f;
#pragma unroll
        for (int j = 0; j < 4; ++j) { v[j] = xr[64 * j]; s2 += (v[j][0] * v[j][0] + v[j][1] * v[j][1]) + (v[j][2] * v[j][2] + v[j][3] * v[j][3]); }
        const float rstd = 1.0f / sqrtf(wave_sum(s2) * (1.0f / DM) + EPS);
        u32x2* o8 = (u32x2*)(XN + (size_t)m * DM) + lane;
#pragma unroll
        for (int j = 0; j < 4; ++j) { u32x2 w; w.x = pk2(v[j][0] * rstd, v[j][1] * rstd); w.y = pk2(v[j][2] * rstd, v[j][3] * rstd); o8[64 * j] = w; }
    }
    const int gt = bid * 512 + tid, NGT = G * 512;
    { const float* wsf = a.in[5]; bf16* wsm = (bf16*)(ws + WS_WSM);
      for (int e = gt; e < 16 * 128 * 128 / 2; e += NGT) { const int idx = 2 * e, s = idx & 127, t = (idx >> 7) & 127;
          const f32x2 w = *(const f32x2*)(wsf + idx); *(unsigned*)(wsm + idx) = pk2(s <= t ? w[0] : 0.f, (s + 1) <= t ? w[1] : 0.f); } }
    { float* rot = (float*)(ws + WS_ROT);
      for (int e = gt; e < SEQ * 32; e += NGT) { const int pos = e >> 5, i = e & 31;
          float inv = 0.f;
#pragma unroll
          for (int k = 0; k < 32; ++k) if (i == k) inv = a.inv_freq[k];
          const float ang = (float)pos * inv;
          const double rev = (double)ang * 0.15915494309189535; const float fr = (float)(rev - rint(rev));
          f32x2 cs; cs[0] = __builtin_amdgcn_cosf(fr); cs[1] = __builtin_amdgcn_sinf(fr); *(f32x2*)(rot + (size_t)e * 2) = cs; } }
}

__device__ __forceinline__ void spatial_phase(LAS unsigned char* lds, const bf16* Z, const float* st1, const bf16* wsm, const float* ln_g, const float* ln_b, const float* bs, bf16* Y, int bid, int G) {
    const int tid = threadIdx.x, lane = tid & 63, wid = tid >> 6, fr = lane & 15, fq = lane >> 4;
    constexpr int VS = 136;
    LAS bf16* vnT = (LAS bf16*)lds;
    LAS f32x2* stat = (LAS f32x2*)(lds + 128 * VS * 2);
    const int dw = wid & 1, tw = wid >> 1;
    for (int unit = bid; unit < 2048; unit += G) {
        const int c = unit >> 4, g = unit & 15, row0 = c * 128, ch0 = g * 128;
        if (tid < 128) {
            const f32x4* p = (const f32x4*)(st1 + (size_t)(row0 + tid) * 64);
            float s = 0.f, q = 0.f;
#pragma unroll
            for (int i = 0; i < 16; ++i) { const f32x4 v = p[i]; s += v[0] + v[2]; q += v[1] + v[3]; }
            const float mean = s * (1.0f / AW), var = q * (1.0f / AW) - mean * mean;
            f32x2 o; o[0] = mean; o[1] = 1.0f / sqrtf(var + EPS); stat[tid] = o;
        }
        __syncthreads();
#pragma unroll
        for (int k = 0; k < 2; ++k) {
            const int it = tid + 512 * k, a2 = (it >> 4) * 2, cg8 = (it & 15) * 8;
            const bf16* p0 = Z + (size_t)(row0 + a2) * NZ + AW + ch0 + cg8;
            const u32x4 r0 = *(const u32x4*)p0, r1 = *(const u32x4*)(p0 + NZ);
            const f32x2 s0 = stat[a2], s1 = stat[a2 + 1];
            const f32x4 g0 = *(const f32x4*)(ln_g + ch0 + cg8), g1 = *(const f32x4*)(ln_g + ch0 + cg8 + 4);
            const f32x4 b0 = *(const f32x4*)(ln_b + ch0 + cg8), b1 = *(const f32x4*)(ln_b + ch0 + cg8 + 4);
#pragma unroll
            for (int e = 0; e < 8; ++e) {
                const unsigned w0 = r0[e >> 1], w1 = r1[e >> 1];
                const float v0 = (e & 1) ? bfhi(w0) : bflo(w0), v1 = (e & 1) ? bfhi(w1) : bflo(w1);
                const float gg = e < 4 ? g0[e & 3] : g1[e & 3], bb = e < 4 ? b0[e & 3] : b1[e & 3];
                const float n0 = (v0 - s0[0]) * s0[1] * gg + bb, n1 = (v1 - s1[0]) * s1[1] * gg + bb;
                *(LAS unsigned*)(vnT + (cg8 + e) * VS + a2) = pk2(n0, n1);
            }
        }
        __syncthreads();
        f32x4 acc[4][2];
#pragma unroll
        for (int m = 0; m < 4; ++m)
#pragma unroll
            for (int n = 0; n < 2; ++n) acc[m][n] = (f32x4){0.f, 0.f, 0.f, 0.f};
        for (int ks = 0; ks <= tw; ++ks) {
            bf16x8 A[4], B[2];
#pragma unroll
            for (int m = 0; m < 4; ++m) A[m] = *(const LAS bf16x8*)(vnT + (64 * dw + 16 * m + fr) * VS + 32 * ks + 8 * fq);
#pragma unroll
            for (int n = 0; n < 2; ++n) B[n] = *(const bf16x8*)(wsm + ((size_t)g * 128 + 32 * tw + 16 * n + fr) * 128 + 32 * ks + 8 * fq);
#pragma unroll
            for (int m = 0; m < 4; ++m)
#pragma unroll
                for (int n = 0; n < 2; ++n) acc[m][n] = __builtin_amdgcn_mfma_f32_16x16x32_bf16(A[m], B[n], acc[m][n], 0, 0, 0);
        }
#pragma unroll
        for (int n = 0; n < 2; ++n) { const int t = 32 * tw + 16 * n + fr; const size_t row = (size_t)(row0 + t); const float bias = bs[g * 128 + t];
#pragma unroll
            for (int m = 0; m < 4; ++m) { const int col = ch0 + 64 * dw + 16 * m + 4 * fq;
                const u32x2 uu = *(const u32x2*)(Z + row * NZ + col), gt = *(const u32x2*)(Z + row * NZ + 2 * AW + col);
                const f32x4 sv = acc[m][n] + bias;
                const float y0 = bflo(uu.x) * sv[0] * silu(bflo(gt.x)), y1 = bfhi(uu.x) * sv[1] * silu(bfhi(gt.x));
                const float y2 = bflo(uu.y) * sv[2] * silu(bflo(gt.y)), y3 = bfhi(uu.y) * sv[3] * silu(bfhi(gt.y));
                u32x2 w; w.x = pk2(y0, y1); w.y = pk2(y2, y3); *(u32x2*)(Y + row * AW + col) = w; } }
        __syncthreads();
    }
}

__device__ __forceinline__ int crow(int r, int hi) { return (r & 3) + 8 * (r >> 2) + 4 * hi; }
__device__ __forceinline__ void attn_phase(LAS unsigned char* lds, const bf16* Q, const bf16* Gt, const bf16* Kb, const bf16* Vb, const float* sinks, bf16* Y2, int bid, int G) {
    const int tid = threadIdx.x, lane = tid & 63, wid = tid >> 6, q31 = lane & 31, hi = lane >> 5;
    constexpr int KS = 72, VS = 264;
    LAS bf16* Ks = (LAS bf16*)lds;
    LAS bf16* Vt = (LAS bf16*)(lds + 256 * KS * 2);
    const float NEG = -INFINITY;
    for (int unit = bid; unit < 256; unit += G) {
        const int kvh = unit & 1, n = (unit >> 1) & 31, b = unit >> 6;
        const int row0 = b * SEQ + n * 128;
#pragma unroll
        for (int k = 0; k < 4; ++k) { const int idx = tid + 512 * k, r = idx >> 3, c8 = (idx & 7) * 8;
            u32x4 v = (u32x4){0u, 0u, 0u, 0u};
            if (n > 0 || r >= 128) v = *(const u32x4*)(Kb + (size_t)(row0 - 128 + r) * 128 + kvh * 64 + c8);
            *(LAS u32x4*)(Ks + r * KS + c8) = v; }
#pragma unroll
        for (int k = 0; k < 2; ++k) { const int it = tid + 512 * k, a2 = (it >> 3) * 2, d8 = (it & 7) * 8;
            u32x4 r0 = (u32x4){0u, 0u, 0u, 0u}, r1 = r0;
            if (n > 0 || a2 >= 128) { const bf16* p = Vb + (size_t)(row0 - 128 + a2) * 128 + kvh * 64 + d8; r0 = *(const u32x4*)p; r1 = *(const u32x4*)(p + 128); }
#pragma unroll
            for (int e = 0; e < 8; ++e) { const unsigned w0 = r0[e >> 1], w1 = r1[e >> 1];
                const unsigned lo = (e & 1) ? (w0 >> 16) : (w0 & 0xffffu), hh = (e & 1) ? (w1 & 0xffff0000u) : (w1 << 16);
                *(LAS unsigned*)(Vt + (d8 + e) * VS + a2) = lo | hh; } }
        __syncthreads();
        const int hq = kvh * 8 + wid; const float sink2 = sinks[hq] * LOG2E;
#pragma unroll 1
        for (int qb = 0; qb < 4; ++qb) {
            const size_t grow = (size_t)(row0 + 32 * qb + q31);
            bf16x8 qf[4];
#pragma unroll
            for (int d0 = 0; d0 < 4; ++d0) qf[d0] = *(const bf16x8*)(Q + grow * 1024 + hq * 64 + 16 * d0 + 8 * hi);
            f32x16 s[5];
#pragma unroll
            for (int i = 0; i < 5; ++i) {
#pragma unroll
                for (int r = 0; r < 16; ++r) s[i][r] = 0.f;
#pragma unroll
                for (int d0 = 0; d0 < 4; ++d0) { const bf16x8 kf = *(const LAS bf16x8*)(Ks + (32 * (qb + i) + q31) * KS + 16 * d0 + 8 * hi);
                    s[i] = __builtin_amdgcn_mfma_f32_32x32x16_bf16(kf, qf[d0], s[i], 0, 0, 0); } }
#pragma unroll
            for (int r = 0; r < 16; ++r) { const int cr = crow(r, hi); if (!(cr > q31)) s[0][r] = NEG; if (cr > q31) s[4][r] = NEG; }
            if (n == 0) {
#pragma unroll
                for (int i = 0; i < 4; ++i) if (qb + i < 4) {
#pragma unroll
                    for (int r = 0; r < 16; ++r) s[i][r] = NEG; } }
            float mx = sink2;
#pragma unroll
            for (int i = 0; i < 5; ++i)
#pragma unroll
                for (int r = 0; r < 16; ++r) mx = fmaxf(mx, s[i][r]);
            mx = fmaxf(mx, __shfl_xor(mx, 32));
            float sum = 0.f;
#pragma unroll
            for (int i = 0; i < 5; ++i)
#pragma unroll
                for (int r = 0; r < 16; ++r) { const float p = __builtin_amdgcn_exp2f(s[i][r] - mx); s[i][r] = p; sum += p; }
            sum += __shfl_xor(sum, 32);
            const float inv = 1.0f / (sum + __builtin_amdgcn_exp2f(sink2 - mx));
            f32x16 o[2];
#pragma unroll
            for (int r = 0; r < 16; ++r) { o[0][r] = 0.f; o[1][r] = 0.f; }
#pragma unroll
            for (int i = 0; i < 5; ++i)
#pragma unroll
                for (int sl = 0; sl < 2; ++sl) {
                    u32x4 pw; pw.x = pk2(s[i][8 * sl + 0], s[i][8 * sl + 1]); pw.y = pk2(s[i][8 * sl + 2], s[i][8 * sl + 3]); pw.z = pk2(s[i][8 * sl + 4], s[i][8 * sl + 5]); pw.w = pk2(s[i][8 * sl + 6], s[i][8 * sl + 7]);
                    const bf16x8 pf = __builtin_bit_cast(bf16x8, pw);
#pragma unroll
                    for (int dh = 0; dh < 2; ++dh) { const LAS bf16* vb = Vt + (32 * dh + q31) * VS + 32 * (qb + i) + 16 * sl + 4 * hi;
                        const s16x4 lo = *(const LAS s16x4*)vb, h4 = *(const LAS s16x4*)(vb + 8);
                        const bf16x8 vf = (bf16x8){lo[0], lo[1], lo[2], lo[3], h4[0], h4[1], h4[2], h4[3]};
                        o[dh] = __builtin_amdgcn_mfma_f32_32x32x16_bf16(vf, pf, o[dh], 0, 0, 0); } }
#pragma unroll
            for (int dh = 0; dh < 2; ++dh)
#pragma unroll
                for (int rg = 0; rg < 4; ++rg) { const size_t off = grow * 1024 + hq * 64 + 32 * dh + 8 * rg + 4 * hi;
                    const u32x2 gt = *(const u32x2*)(Gt + off);
                    const float y0 = o[dh][4 * rg + 0] * inv * silu(bflo(gt.x)), y1 = o[dh][4 * rg + 1] * inv * silu(bfhi(gt.x));
                    const float y2 = o[dh][4 * rg + 2] * inv * silu(bflo(gt.y)), y3 = o[dh][4 * rg + 3] * inv * silu(bfhi(gt.y));
                    u32x2 w; w.x = pk2(y0, y1); w.y = pk2(y2, y3); *(u32x2*)(Y2 + off) = w; }
        }
        __syncthreads();
    }
}

__global__ void __launch_bounds__(512, 2) yoco_fwd(Args a) {
    extern __shared__ __attribute__((aligned(16))) unsigned char lds_raw[];
    LAS unsigned char* lds = (LAS unsigned char*)lds_raw;
    cg::grid_group grid = cg::this_grid();
    const int bid = blockIdx.x, G = gridDim.x;
    unsigned char* ws = a.ws;
    bf16* Ybuf = (bf16*)a.out;

    p0_prologue(a, lds, bid, G);
    grid.sync();

    {
        pg8::Gemm g{(const bf16*)(ws + WS_XN), (const bf16*)(ws + WS_WIN), M, NZ, DM}; pg8::StaticOrder S; S.init(M, NZ, G, bid);
        pg8::EpiZ E{(bf16*)(ws + WS_Z), (float*)(ws + WS_ST1)};
        pg8::gemm_phase<pg8::EpiZ, pg8::StaticOrder, true, true>(lds, g, S, E);
    }
    grid.sync();

    spatial_phase(lds, (const bf16*)(ws + WS_Z), (const float*)(ws + WS_ST1), (const bf16*)(ws + WS_WSM), a.in[3], a.in[4], a.in[6], Ybuf, bid, G);
    grid.sync();

    {
        pg8::Gemm g{Ybuf, (const bf16*)(ws + WS_WOA), M, DM, AW}; pg8::StaticOrder S; S.init(M, DM, G, bid);
        pg8::EpiRes E{a.in[0], (float*)(ws + WS_H), (bf16*)(ws + WS_HB), (float*)(ws + WS_ST2)};
        pg8::gemm_phase<pg8::EpiRes, pg8::StaticOrder, true, true>(lds, g, S, E);
    }
    grid.sync();

    {
        pg8::Gemm g{(const bf16*)(ws + WS_HB), (const bf16*)(ws + WS_WCAT), M, NQKV, DM}; pg8::StaticOrder S; S.init(M, NQKV, G, bid);
        pg8::EpiQKV E{(const float*)(ws + WS_ST2), (const float*)(ws + WS_ROT), a.in[13], a.in[10], (bf16*)(ws + WS_Q), (bf16*)(ws + WS_G), (bf16*)(ws + WS_K), (bf16*)(ws + WS_V)};
        pg8::gemm_phase<pg8::EpiQKV, pg8::StaticOrder, true, true>(lds, g, S, E);
    }
    grid.sync();

    attn_phase(lds, (const bf16*)(ws + WS_Q), (const bf16*)(ws + WS_G), (const bf16*)(ws + WS_K), (const bf16*)(ws + WS_V), a.in[14], (bf16*)(ws + WS_Y2), bid, G);
    grid.sync();

    {
        pg8::Gemm g{(const bf16*)(ws + WS_Y2), (const bf16*)(ws + WS_WOB), M, DM, DM}; pg8::StaticOrder S; S.init(M, DM, G, bid);
        pg8::EpiRes E{(const float*)(ws + WS_H), a.out, nullptr, (float*)(ws + WS_ST3)};
        pg8::gemm_phase<pg8::EpiRes, pg8::StaticOrder, true, true>(lds, g, S, E);
    }
    grid.sync();

    {
        const int lane = threadIdx.x & 63, gw = bid * 8 + (threadIdx.x >> 6), NGW = G * 8;
        const float* st3 = (const float*)(ws + WS_ST3); const f32x4* gp = (const f32x4*)a.in[16] + lane;
        f32x4 gv[4];
#pragma unroll
        for (int j = 0; j < 4; ++j) gv[j] = gp[64 * j];
        for (int m = gw; m < M; m += NGW) {
            const f32x4* p = (const f32x4*)(st3 + (size_t)m * 16); const f32x4 s4 = (p[0] + p[1]) + (p[2] + p[3]);
            const float rstd = 1.0f / sqrtf(((s4[0] + s4[1]) + (s4[2] + s4[3])) * (1.0f / DM) + EPS);
            f32x4* xr = (f32x4*)(a.out + (size_t)m * DM) + lane;
#pragma unroll
            for (int j = 0; j < 4; ++j) xr[64 * j] = xr[64 * j] * rstd * gv[j];
        }
    }
}

extern "C" void kernel_launch(void* const* d_in, const int* in_sizes, int n_in, void* d_out, int out_size, void* d_ws, size_t ws_size, hipStream_t stream) {
    static int grid = 0;
    if (grid == 0) {
        if (n_in != 17 || in_sizes[0] != M * DM || out_size != M * DM || ws_size < WS_END) { fprintf(stderr, "kernel_launch: unexpected shapes (n_in %d, in0 %d, out %d, ws %zu)\n", n_in, n_in > 0 ? in_sizes[0] : -1, out_size, ws_size); grid = -1; return; }
        int dev = 0, cus = 0, per_cu = 0;
        hipGetDevice(&dev); hipDeviceGetAttribute(&cus, hipDeviceAttributeMultiprocessorCount, dev);
        hipFuncSetAttribute((const void*)yoco_fwd, hipFuncAttributeMaxDynamicSharedMemorySize, LDS_BYTES);
        hipOccupancyMaxActiveBlocksPerMultiprocessor(&per_cu, (const void*)yoco_fwd, 512, LDS_BYTES);
        (void)hipGetLastError();
        if (per_cu < 1) per_cu = 1;
        grid = cus * 1;
        if (grid <= 0) grid = 256;
    }
    if (grid < 0) return;
    Args a{};
    for (int i = 0; i < 17; ++i) a.in[i] = (const float*)d_in[i];
    a.out = (float*)d_out; a.ws = (unsigned char*)d_ws;
    for (int i = 0; i < 32; ++i) a.inv_freq[i] = powf(10000.0f, -(float)(2 * i) / 64.0f);
    void* args[] = {&a};
    hipError_t e = hipLaunchCooperativeKernel((const void*)yoco_fwd, dim3(grid), dim3(512), args, LDS_BYTES, stream);
    if (e != hipSuccess) fprintf(stderr, "cooperative launch failed: %s (grid %d)\n", hipGetErrorString(e), grid);
}
```

```cpp
#include <hip/hip_runtime.h>
#include <hip/hip_cooperative_groups.h>
#include <cstdio>
#include <cstdint>
#include <cmath>
namespace cg = cooperative_groups;
namespace pg8 {
#define PG8_LAS __attribute__((address_space(3)))
typedef unsigned short bf16_t;
typedef short bf16x8 __attribute__((ext_vector_type(8)));
typedef float f32x4 __attribute__((ext_vector_type(4)));
typedef unsigned u32x4 __attribute__((ext_vector_type(4)));
constexpr int BM = 256, BK = 64, HALF = 128, HTB = HALF * BK * 2  , STAGE_BYTES = 8 * HTB, NXCD = 8, WGM = 8;

__host__ __device__ __forceinline__ int lds_byte(int r, int c) { const int st = (r >> 4) * 2 + (c >> 5), rr = r & 15, cc = c & 31, ob = rr * 64 + cc * 2; return st * 1024 + (ob ^ (((ob >> 9) & 1) << 5)); }
__host__ __device__ __forceinline__ void stage_rc(int b, int& R, int& C) { const int st = b / 1024, sb = b % 1024, swz = sb ^ (((sb >> 9) & 1) << 5); R = (st >> 1) * 16 + swz / 64; C = (st & 1) * 32 + (swz % 64) / 2; }
__host__ __device__ __forceinline__ int perm32(int rho) { const int n = rho >> 4, i = rho & 15; return 8 * (i >> 2) + 4 * n + (i & 3); }

struct Unit { int pm, pn; };
struct Gemm { const bf16_t* A; const bf16_t* Bt; int M, N, K; };

struct StaticOrder {
    int nM, nN, nwg, G, c;
    __host__ __device__ void init(int M, int N, int G_, int c_) { nM = M / BM; nN = N / BM; nwg = nM * nN; G = G_; c = c_; }
    __host__ __device__ bool next(int i, Unit& u) const {
        const long L = (long)i * G + c; if (L >= nwg) return false;
        int wgid = (int)L; { const int q = nwg / NXCD, r = nwg % NXCD, xcd = wgid % NXCD, off = wgid / NXCD; wgid = (xcd < r ? xcd * (q + 1) : r * (q + 1) + (xcd - r) * q) + off; }
        const int nig = WGM * nN, gid = wgid / nig, fm = gid * WGM, gsz = (nM - fm) < WGM ? (nM - fm) : WGM;
        u.pm = fm + ((wgid % nig) % gsz); u.pn = (wgid % nig) / gsz; return true;
    }
    __device__ __forceinline__ void a_ready(const Unit&) const {}
    __device__ __forceinline__ void done(const Unit&) const {}
};

__device__ __forceinline__ unsigned cvt_pk_bf16(float lo, float hi) { unsigned r; asm volatile("v_cvt_pk_bf16_f32 %0, %1, %2" : "=v"(r) : "v"(lo), "v"(hi)); return r; }
typedef float f32x2 __attribute__((ext_vector_type(2)));
typedef unsigned u32x2 __attribute__((ext_vector_type(2)));
__device__ __forceinline__ unsigned pkbf(float lo, float hi) { unsigned r; asm("v_cvt_pk_bf16_f32 %0, %1, %2" : "=v"(r) : "v"(lo), "v"(hi)); return r; }
constexpr float RMS_EPS = 1e-5f;

struct EpiZ {
    static constexpr bool PERM = true, AFTER_DRAIN = false;
    bf16_t* Z; float* st;
    __device__ __forceinline__ void operator()(const f32x4 (&acc)[2][2][4][2], const Unit& u, int wr, int wc, int fr, int fq) const {
        const int row0 = u.pm * BM + wr * 64 + fr, col0 = u.pn * BM + wc * 32 + 8 * fq;
        const bool isv = (u.pn >= 8 && u.pn < 16);
#pragma unroll
        for (int ai = 0; ai < 2; ++ai)
#pragma unroll
            for (int m = 0; m < 4; ++m) { const int row = row0 + ai * HALF + m * 16; bf16_t* rowp = Z + (size_t)row * 6144 + col0;
                float s = 0.f, q = 0.f;
#pragma unroll
                for (int bj = 0; bj < 2; ++bj) { const f32x4 v0 = acc[ai][bj][m][0], v1 = acc[ai][bj][m][1];
                    u32x4 w; w.x = pkbf(v0[0], v0[1]); w.y = pkbf(v0[2], v0[3]); w.z = pkbf(v1[0], v1[1]); w.w = pkbf(v1[2], v1[3]);
                    *(u32x4*)(rowp + bj * HALF) = w;
                    s += (v0[0] + v0[1]) + (v0[2] + v0[3]) + (v1[0] + v1[1]) + (v1[2] + v1[3]);
                    q += (v0[0] * v0[0] + v0[1] * v0[1]) + (v0[2] * v0[2] + v0[3] * v0[3]) + (v1[0] * v1[0] + v1[1] * v1[1]) + (v1[2] * v1[2] + v1[3] * v1[3]); }
                if (isv) { s += __shfl_xor(s, 16); s += __shfl_xor(s, 32); q += __shfl_xor(q, 16); q += __shfl_xor(q, 32);
                    if (fq == 0) { f32x2 o; o.x = s; o.y = q; *(f32x2*)(st + ((size_t)row * 32 + (u.pn - 8) * 4 + wc) * 2) = o; } }
            }
    }
};

struct EpiRes {
    static constexpr bool PERM = false, AFTER_DRAIN = false;
    const float* base; float* out; bf16_t* outb; float* st;
    __device__ __forceinline__ void operator()(const f32x4 (&acc)[2][2][4][2], const Unit& u, int wr, int wc, int fr, int fq) const {
        const int row0 = u.pm * BM + wr * 64 + fr, col0 = u.pn * BM + wc * 32 + 4 * fq;
#pragma unroll
        for (int ai = 0; ai < 2; ++ai)
#pragma unroll
            for (int m = 0; m < 4; ++m) { const int row = row0 + ai * HALF + m * 16; const size_t off = (size_t)row * 1024 + col0; float q = 0.f;
#pragma unroll
                for (int bj = 0; bj < 2; ++bj)
#pragma unroll
                    for (int n = 0; n < 2; ++n) { const f32x4 b = *(const f32x4*)(base + off + bj * HALF + n * 16); const f32x4 h = b + acc[ai][bj][m][n];
                        *(f32x4*)(out + off + bj * HALF + n * 16) = h;
                        if (outb) { u32x2 w; w.x = pkbf(h[0], h[1]); w.y = pkbf(h[2], h[3]); *(u32x2*)(outb + off + bj * HALF + n * 16) = w; }
                        q += (h[0] * h[0] + h[1] * h[1]) + (h[2] * h[2] + h[3] * h[3]); }
                q += __shfl_xor(q, 16); q += __shfl_xor(q, 32);
                if (fq == 0) st[(size_t)row * 16 + u.pn * 4 + wc] = q;
            }
    }
};

struct EpiQKV {
    static constexpr bool PERM = false, AFTER_DRAIN = false;
    const float* st2; const float* rot; const float* bq; const float* bkv; bf16_t* Q; bf16_t* Gt; bf16_t* Kb; bf16_t* Vb;
    __device__ __forceinline__ void operator()(const f32x4 (&acc)[2][2][4][2], const Unit& u, int wr, int wc, int fr, int fq) const {
        const int row0 = u.pm * BM + wr * 64 + fr;
        float rs[2][4];
#pragma unroll
        for (int ai = 0; ai < 2; ++ai)
#pragma unroll
            for (int m = 0; m < 4; ++m) { const f32x4* p = (const f32x4*)(st2 + (size_t)(row0 + ai * HALF + m * 16) * 16); const f32x4 a = (p[0] + p[1]) + (p[2] + p[3]);
                rs[ai][m] = 1.0f / sqrtf(((a[0] + a[1]) + (a[2] + a[3])) * (1.0f / 1024.0f) + RMS_EPS); }
        if (u.pn >= 4 && u.pn < 8) {
            const int col0 = (u.pn - 4) * BM + wc * 32 + 4 * fq;
#pragma unroll
            for (int ai = 0; ai < 2; ++ai)
#pragma unroll
                for (int m = 0; m < 4; ++m) { const int row = row0 + ai * HALF + m * 16; const float r = rs[ai][m];
#pragma unroll
                    for (int bj = 0; bj < 2; ++bj)
#pragma unroll
                        for (int n = 0; n < 2; ++n) { const f32x4 v = acc[ai][bj][m][n] * r; u32x2 w; w.x = pkbf(v[0], v[1]); w.y = pkbf(v[2], v[3]);
                            *(u32x2*)(Gt + (size_t)row * 1024 + col0 + bj * HALF + n * 16) = w; } }
            return;
        }
        const bool isq = (u.pn < 4);
        const int i0 = (wc & 1) * 16 + 4 * fq;
#pragma unroll
        for (int bj = 0; bj < 2; ++bj) {
            if (!isq && bj == 1) {
                const int col0 = wc * 32 + 4 * fq;
#pragma unroll
                for (int n = 0; n < 2; ++n) { const f32x4 bv = *(const f32x4*)(bkv + 128 + col0 + n * 16);
#pragma unroll
                    for (int ai = 0; ai < 2; ++ai)
#pragma unroll
                        for (int m = 0; m < 4; ++m) { const int row = row0 + ai * HALF + m * 16; const f32x4 v = acc[ai][1][m][n] * rs[ai][m] + bv;
                            u32x2 w; w.x = pkbf(v[0], v[1]); w.y = pkbf(v[2], v[3]); *(u32x2*)(Vb + (size_t)row * 128 + col0 + n * 16) = w; } }
            } else {
                const int head = isq ? (u.pn * 4 + bj * 2 + (wc >> 1)) : (wc >> 1);
                const float* bias = (isq ? bq : bkv) + head * 64 + i0;
                const f32x4 b1 = *(const f32x4*)(bias), b2 = *(const f32x4*)(bias + 32);
                const float sc = isq ? (0.125f * 1.4426950408889634f) : 1.0f;
                bf16_t* dstb = isq ? (Q + head * 64 + i0) : (Kb + head * 64 + i0); const int ldo = isq ? 1024 : 128;
#pragma unroll
                for (int ai = 0; ai < 2; ++ai)
#pragma unroll
                    for (int m = 0; m < 4; ++m) { const int row = row0 + ai * HALF + m * 16; const int pos = row & 4095;
                        const f32x4* rp = (const f32x4*)(rot + ((size_t)pos * 32 + i0) * 2); const f32x4 cs0 = rp[0], cs1 = rp[1];
                        const f32x4 x1 = acc[ai][bj][m][0] * rs[ai][m] + b1, x2 = acc[ai][bj][m][1] * rs[ai][m] + b2;
                        const float c[4] = {cs0[0], cs0[2], cs1[0], cs1[2]}, s[4] = {cs0[1], cs0[3], cs1[1], cs1[3]};
                        float o1[4], o2[4];
#pragma unroll
                        for (int j = 0; j < 4; ++j) { o1[j] = (x1[j] * c[j] - x2[j] * s[j]) * sc; o2[j] = (x2[j] * c[j] + x1[j] * s[j]) * sc; }
                        u32x2 w1, w2; w1.x = pkbf(o1[0], o1[1]); w1.y = pkbf(o1[2], o1[3]); w2.x = pkbf(o2[0], o2[1]); w2.y = pkbf(o2[2], o2[3]);
                        bf16_t* d = dstb + (size_t)row * ldo; *(u32x2*)d = w1; *(u32x2*)(d + 32) = w2; }
            }
        }
    }
};

template <class Epi, class Sched, bool ALIGN_EPI = false, bool SP2 = false>
__device__ __forceinline__ void gemm_phase(PG8_LAS unsigned char* lds, const Gemm g, const Sched& S, const Epi& E) {
    const int tid = threadIdx.x, wid = __builtin_amdgcn_readfirstlane(tid >> 6), lane = tid & 63, wr = wid >> 2, wc = wid & 3, fr = lane & 15, fq = lane >> 4;
    const int K = g.K, nt = K / BK;
    unsigned voffA[2], voffB[2];
#pragma unroll
    for (int i = 0; i < 2; ++i) { int R, C; stage_rc(tid * 16 + i * 8192, R, C); const int Rb = Epi::PERM ? ((R & ~31) + perm32(R & 31)) : R;
        voffA[i] = (unsigned)(R * K + C) * 2u; voffB[i] = (unsigned)(Rb * K + C) * 2u; }
    const size_t kstep = (size_t)(BK * 2);
    const size_t hstep = (size_t)HALF * K * 2;
    const size_t tstep = 2 * hstep;
    const unsigned ldsw = (unsigned)wid * 1024u;
    const int aoff = lds_byte(wr * 64 + fr, fq * 8), boff = lds_byte(wc * 32 + fr, fq * 8);
#define PG8_SA(b, h) (((b) * 2 + (h)) * HTB)
#define PG8_SB(b, h) ((4 + (b) * 2 + (h)) * HTB)
#define PG8_STAGE(bufoff, gbase, voff) do { _Pragma("unroll") for (int _i = 0; _i < 2; ++_i) \
        __builtin_amdgcn_global_load_lds((const unsigned*)((const char*)(gbase) + (voff)[_i]), (PG8_LAS unsigned*)(lds + (bufoff) + ldsw + _i * 8192), 16, 0, 0); } while (0)
#define PG8_LDA(dst, b, h) do { _Pragma("unroll") for (int m = 0; m < 4; ++m) _Pragma("unroll") for (int k = 0; k < 2; ++k) dst[m][k] = *(const PG8_LAS bf16x8*)(lds + PG8_SA(b, h) + aoff + m * 2048 + k * 1024); } while (0)
#define PG8_LDB(dst, b, h) do { _Pragma("unroll") for (int n = 0; n < 2; ++n) _Pragma("unroll") for (int k = 0; k < 2; ++k) dst[n][k] = *(const PG8_LAS bf16x8*)(lds + PG8_SB(b, h) + boff + n * 2048 + k * 1024); } while (0)
#define PG8_MMA(ai, bj, At, Bt) do { __builtin_amdgcn_s_setprio(1); _Pragma("unroll") for (int m = 0; m < 4; ++m) _Pragma("unroll") for (int n = 0; n < 2; ++n) _Pragma("unroll") for (int k = 0; k < 2; ++k) \
        acc[ai][bj][m][n] = __builtin_amdgcn_mfma_f32_16x16x32_bf16(Bt[n][k], At[m][k], acc[ai][bj][m][n], 0, 0, 0); __builtin_amdgcn_s_setprio(0); } while (0)
#define PG8_WAIT_V(n) asm volatile("s_waitcnt vmcnt(" #n ")" ::: "memory")
#define PG8_WAIT_L(n) asm volatile("s_waitcnt lgkmcnt(" #n ")" ::: "memory")
#define PG8_BAR __builtin_amdgcn_s_barrier()
#define PG8_SCHED __builtin_amdgcn_sched_barrier(0)
    Unit cur, nxt; int ui = 0;
    if (!S.next(0, cur)) return;
    f32x4 acc[2][2][4][2];
#pragma unroll
    for (int a = 0; a < 2; ++a)
#pragma unroll
        for (int b = 0; b < 2; ++b)
#pragma unroll
            for (int m = 0; m < 4; ++m)
#pragma unroll
                for (int n = 0; n < 2; ++n) acc[a][b][m][n] = (f32x4){0.f, 0.f, 0.f, 0.f};
    bf16x8 At[4][2], B0[2][2], B1[2][2];
    const char* cA = (const char*)g.A + (size_t)cur.pm * tstep; const char* cB = (const char*)g.Bt + (size_t)cur.pn * tstep;
    S.a_ready(cur);
    if constexpr (SP2) {
        PG8_STAGE(PG8_SB(0, 0), cB, voffB); PG8_STAGE(PG8_SB(0, 1), cB + hstep, voffB); PG8_STAGE(PG8_SA(0, 0), cA, voffA); PG8_STAGE(PG8_SA(0, 1), cA + hstep, voffA);
        if (wr == 1) PG8_BAR;
        PG8_WAIT_V(2); PG8_BAR;
        PG8_STAGE(PG8_SB(1, 0), cB + kstep, voffB); PG8_STAGE(PG8_SA(1, 0), cA + kstep, voffA); PG8_STAGE(PG8_SB(1, 1), cB + hstep + kstep, voffB);
        PG8_WAIT_V(6); PG8_BAR;
    } else {
        PG8_STAGE(PG8_SB(0, 0), cB, voffB); PG8_STAGE(PG8_SA(0, 0), cA, voffA); PG8_STAGE(PG8_SB(0, 1), cB + hstep, voffB); PG8_STAGE(PG8_SA(0, 1), cA + hstep, voffA);
        if (wr == 1) PG8_BAR;
        PG8_WAIT_V(4); PG8_BAR;
        PG8_STAGE(PG8_SB(1, 0), cB + kstep, voffB); PG8_STAGE(PG8_SA(1, 0), cA + kstep, voffA); PG8_STAGE(PG8_SB(1, 1), cB + hstep + kstep, voffB);
        PG8_WAIT_V(6); PG8_BAR;
    }
    for (;;) {
        const bool has_next = S.next(ui + 1, nxt);
        const char* nA = has_next ? (const char*)g.A + (size_t)nxt.pm * tstep : cA; const char* nB = has_next ? (const char*)g.Bt + (size_t)nxt.pn * tstep : cB;
        for (int t = 0; t < nt; t += 2) {
            const bool last = (t == nt - 2);
            const char* a1 = cA + (size_t)(t + 1) * kstep;
            const char* a2 = last ? nA : cA + (size_t)(t + 2) * kstep; const char* b2 = last ? nB : cB + (size_t)(t + 2) * kstep;
            const char* a3 = a2 + kstep; const char* b3 = b2 + kstep;
            if (last && has_next) S.a_ready(nxt);
            if constexpr (SP2) {
            PG8_LDB(B0, 0, 0); PG8_LDB(B1, 0, 1); PG8_SCHED; PG8_LDA(At, 0, 0); PG8_STAGE(PG8_SA(1, 1), a1 + hstep, voffA);
            PG8_WAIT_V(8); PG8_WAIT_L(0); PG8_BAR; PG8_MMA(0, 0, At, B0); PG8_MMA(0, 1, At, B1); PG8_BAR; PG8_SCHED;
            PG8_LDA(At, 0, 1); PG8_STAGE(PG8_SB(0, 0), b2, voffB); PG8_STAGE(PG8_SB(0, 1), b2 + hstep, voffB); PG8_STAGE(PG8_SA(0, 0), a2, voffA);
            PG8_WAIT_V(8); PG8_WAIT_L(0); PG8_BAR; PG8_MMA(1, 0, At, B0); PG8_MMA(1, 1, At, B1); PG8_BAR; PG8_SCHED;
            PG8_LDB(B0, 1, 0); PG8_LDB(B1, 1, 1); PG8_SCHED; PG8_LDA(At, 1, 0); PG8_STAGE(PG8_SA(0, 1), a2 + hstep, voffA);
            PG8_WAIT_V(8); PG8_WAIT_L(0); PG8_BAR; PG8_MMA(0, 0, At, B0); PG8_MMA(0, 1, At, B1); PG8_BAR; PG8_SCHED;
            PG8_LDA(At, 1, 1); PG8_STAGE(PG8_SB(1, 0), b3, voffB); PG8_STAGE(PG8_SB(1, 1), b3 + hstep, voffB); PG8_STAGE(PG8_SA(1, 0), a3, voffA);
            PG8_WAIT_V(8); PG8_WAIT_L(0); PG8_BAR; PG8_MMA(1, 0, At, B0); PG8_MMA(1, 1, At, B1); PG8_BAR; PG8_SCHED;
            } else {
            PG8_LDB(B0, 0, 0); PG8_SCHED; PG8_LDA(At, 0, 0); PG8_STAGE(PG8_SA(1, 1), a1 + hstep, voffA);
            PG8_WAIT_L(8); PG8_BAR; PG8_WAIT_L(0); PG8_MMA(0, 0, At, B0); PG8_BAR; PG8_SCHED;
            PG8_LDB(B1, 0, 1); PG8_STAGE(PG8_SB(0, 0), b2, voffB);
            PG8_BAR; PG8_WAIT_L(0); PG8_MMA(0, 1, At, B1); PG8_BAR;
            PG8_LDA(At, 0, 1); PG8_STAGE(PG8_SA(0, 0), a2, voffA);
            PG8_BAR; PG8_WAIT_L(0); PG8_MMA(1, 0, At, B0); PG8_BAR; PG8_SCHED;
            PG8_STAGE(PG8_SB(0, 1), b2 + hstep, voffB);
            PG8_WAIT_V(6); PG8_BAR; PG8_MMA(1, 1, At, B1); PG8_BAR;
            PG8_LDB(B0, 1, 0); PG8_SCHED; PG8_LDA(At, 1, 0); PG8_STAGE(PG8_SA(0, 1), a2 + hstep, voffA);
            PG8_WAIT_L(8); PG8_BAR; PG8_WAIT_L(0); PG8_MMA(0, 0, At, B0); PG8_BAR; PG8_SCHED;
            PG8_LDB(B1, 1, 1); PG8_STAGE(PG8_SB(1, 0), b3, voffB);
            PG8_BAR; PG8_WAIT_L(0); PG8_MMA(0, 1, At, B1); PG8_BAR;
            PG8_LDA(At, 1, 1); PG8_STAGE(PG8_SA(1, 0), a3, voffA);
            PG8_BAR; PG8_WAIT_L(0); PG8_MMA(1, 0, At, B0); PG8_BAR; PG8_SCHED;
            PG8_STAGE(PG8_SB(1, 1), b3 + hstep, voffB);
            PG8_WAIT_V(6); PG8_BAR; PG8_MMA(1, 1, At, B1); PG8_BAR;
            }
        }
        if constexpr (ALIGN_EPI) { if (wr == 0) PG8_BAR; }
        if constexpr (!Epi::AFTER_DRAIN) { E(acc, cur, wr, wc, fr, fq); S.done(cur); }
        if (!has_next) break;
#pragma unroll
        for (int a = 0; a < 2; ++a)
#pragma unroll
            for (int b = 0; b < 2; ++b)
#pragma unroll
                for (int m = 0; m < 4; ++m)
#pragma unroll
                    for (int n = 0; n < 2; ++n) acc[a][b][m][n] = (f32x4){0.f, 0.f, 0.f, 0.f};
        cur = nxt; cA = nA; cB = nB; ++ui;
        if constexpr (ALIGN_EPI) { if (wr == 1) PG8_BAR; }
    }
    PG8_WAIT_V(0);
    if constexpr (!ALIGN_EPI) { if (wr == 0) PG8_BAR; }
    PG8_BAR;
    if constexpr (Epi::AFTER_DRAIN) { E.fused(acc, cur, wr, wc, fr, fq, lds, wid, lane); S.done(cur); }
#undef PG8_SA
#undef PG8_SB
#undef PG8_STAGE
#undef PG8_LDA
#undef PG8_LDB
#undef PG8_MMA
#undef PG8_WAIT_V
#undef PG8_WAIT_L
#undef PG8_BAR
#undef PG8_SCHED
}
}

constexpr int M = 16384, DM = 1024, SEQ = 4096, AW = 2048, NZ = 6144, NQKV = 2304;
constexpr float EPS = 1e-5f, LOG2E = 1.4426950408889634f;
constexpr size_t MiB = 1u << 20;
constexpr size_t WS_WIN = 1 * MiB;
constexpr size_t WS_WOA = 13 * MiB;
constexpr size_t WS_WCAT = 17 * MiB;
constexpr size_t WS_WOB = 22 * MiB;
constexpr size_t WS_WSM = 24 * MiB;
constexpr size_t WS_ROT = 25 * MiB;
constexpr size_t WS_ST1 = 26 * MiB;
constexpr size_t WS_ST2 = 30 * MiB;
constexpr size_t WS_ST3 = 31 * MiB;
constexpr size_t WS_Z = 32 * MiB;
constexpr size_t WS_XN = 224 * MiB;
constexpr size_t WS_H = 32 * MiB;
constexpr size_t WS_HB = 96 * MiB;
constexpr size_t WS_Q = 128 * MiB;
constexpr size_t WS_G = 160 * MiB;
constexpr size_t WS_K = 192 * MiB;
constexpr size_t WS_V = 196 * MiB;
constexpr size_t WS_Y2 = 224 * MiB;
constexpr size_t WS_END = 256 * MiB;
constexpr int LDS_BYTES = 131072 + 1024;

#define LAS __attribute__((address_space(3)))
typedef unsigned short bf16;
typedef float f32x2 __attribute__((ext_vector_type(2)));
typedef float f32x4 __attribute__((ext_vector_type(4)));
typedef float f32x16 __attribute__((ext_vector_type(16)));
typedef unsigned u32x2 __attribute__((ext_vector_type(2)));
typedef unsigned u32x4 __attribute__((ext_vector_type(4)));
typedef short bf16x8 __attribute__((ext_vector_type(8)));
typedef short s16x4 __attribute__((ext_vector_type(4)));

__device__ __forceinline__ unsigned pk2(float lo, float hi) { return pg8::pkbf(lo, hi); }
__device__ __forceinline__ float bflo(unsigned w) { return __uint_as_float(w << 16); }
__device__ __forceinline__ float bfhi(unsigned w) { return __uint_as_float(w & 0xffff0000u); }
__device__ __forceinline__ float silu(float x) { return x * __builtin_amdgcn_rcpf(1.0f + __builtin_amdgcn_exp2f(-x * LOG2E)); }
__device__ __forceinline__ float wave_sum(float v) {
#pragma unroll
    for (int o = 1; o < 64; o <<= 1) v += __shfl_xor(v, o);
    return v;
}

__device__ __forceinline__ int rot_phys(int L) {
    const int hit = (L >> 6) & 3, d = L & 63, n = d >> 5, i = d & 31, wlo = i >> 4, i16 = i & 15;
    const int bj = hit >> 1, wc = (hit & 1) * 2 + wlo;
    return 128 * bj + 32 * wc + 16 * n + i16;
}
__device__ __forceinline__ int wrow(int mode, int n) {
    if (mode == 2) return n < 1024 ? ((n & ~255) + rot_phys(n & 255)) : n;
    if (mode == 3) return n < 128 ? (2048 + rot_phys(n)) : (2048 + n);
    return n;
}
__device__ __forceinline__ void p0_transpose_item(const float* W, int K, int N, bf16* WT, const float* gain, int mode, LAS float* scr, int item, int lane) {
    const int nblk = N / 32, kb = item / nblk, nb = item % nblk, k0 = 64 * kb, n0 = 32 * nb;
    float wv[32];
#pragma unroll
    for (int i = 0; i < 32; ++i) { const int kk = 2 * i + (lane >> 5); wv[i] = W[(size_t)(k0 + kk) * N + n0 + (lane & 31)]; }
    if (gain) {
#pragma unroll
        for (int i = 0; i < 32; ++i) wv[i] *= gain[k0 + 2 * i + (lane >> 5)]; }
#pragma unroll
    for (int i = 0; i < 32; ++i) { const int kk = 2 * i + (lane >> 5); scr[kk * 33 + (lane & 31)] = wv[i]; }
    asm volatile("s_waitcnt lgkmcnt(0)" ::: "memory");
    const int c = lane & 7;
#pragma unroll
    for (int j = 0; j < 4; ++j) { const int n = (lane >> 3) + 8 * j; const LAS float* s = scr + (8 * c) * 33 + n;
        u32x4 o; o.x = pk2(s[0 * 33], s[1 * 33]); o.y = pk2(s[2 * 33], s[3 * 33]); o.z = pk2(s[4 * 33], s[5 * 33]); o.w = pk2(s[6 * 33], s[7 * 33]);
        *(u32x4*)(WT + (size_t)wrow(mode, n0 + n) * K + k0 + 8 * c) = o; }
    asm volatile("s_waitcnt lgkmcnt(0)" ::: "memory");
}

#define XB_TMO      128
#define XB_XCNT(j)  (256  + 64 * (j))
#define XB_XSUB(j)  (1280 + 64 * (j))
#define XB_XGEN(j)  (2304 + 64 * (j))
#define XB_TOP      3328
#define XB_TOPGEN   3392
#define XCD_BAR_WORDS 3456
#define XB_SPIN_CAP (1u << 18)

__device__ __forceinline__ unsigned xb_ld(unsigned* p)              { return __hip_atomic_load(p, __ATOMIC_RELAXED, __HIP_MEMORY_SCOPE_AGENT); }
__device__ __forceinline__ unsigned xb_add(unsigned* p, unsigned v) { return __hip_atomic_fetch_add(p, v, __ATOMIC_RELAXED, __HIP_MEMORY_SCOPE_AGENT); }
__device__ __forceinline__ unsigned xb_xcc_id() { return (unsigned)__builtin_amdgcn_s_getreg((3 << 11) | 20) & 0xFu; }
#define XB_SPIN(cond, bar) do { unsigned _sp = 0; while (cond) { __builtin_amdgcn_s_sleep(1); \
    if ((++_sp & 255u) == 0u) { if (xb_ld(&(bar)[XB_TMO])) break; if (_sp > XB_SPIN_CAP) { atomicAdd(&(bar)[XB_TMO], 1u); break; } } } } while (0)

struct XcdBarrier {
    unsigned* bar; unsigned x;
    volatile LAS unsigned* st;
};

__device__ __forceinline__ XcdBarrier xcd_barrier_post(unsigned* bar, volatile LAS unsigned* st) {
    XcdBarrier b; b.bar = bar; b.x = xb_xcc_id(); b.st = st;
    if (threadIdx.x == 0) (void)xb_add(&bar[XB_XCNT(b.x)], 1u);
    return b;
}
__device__ __forceinline__ void xcd_barrier_complete(unsigned* bar, unsigned x, unsigned& nloc, unsigned& nx) {
    const unsigned G = gridDim.x * gridDim.y * gridDim.z;
    unsigned sum, cnt, mine, sp = 0u;
    for (;;) {
        sum = 0u; cnt = 0u; mine = 0u;
#pragma unroll
        for (unsigned j = 0; j < 16; ++j) { const unsigned c = xb_ld(&bar[XB_XCNT(j)]); sum += c; cnt += (c > 0u) ? 1u : 0u; mine = (j == x) ? c : mine; }
        if (sum == G) break;
        __builtin_amdgcn_s_sleep(1);
        if ((++sp & 255u) == 0u) { if (xb_ld(&bar[XB_TMO])) break; if (sp > XB_SPIN_CAP) { atomicAdd(&bar[XB_TMO], 1u); break; } }
    }
    nloc = mine > 0u ? mine : 1u; nx = cnt > 0u ? cnt : 1u;
}

__device__ __forceinline__ void xcd_barrier(const XcdBarrier& b) {
    asm volatile("s_waitcnt vmcnt(0)" ::: "memory");
    __syncthreads();
    if (threadIdx.x == 0) {
        unsigned* bar = b.bar;
        __builtin_amdgcn_s_waitcnt(0);
        unsigned nloc = b.st[0], nx = b.st[1];
        if (nloc == 0u) { xcd_barrier_complete(bar, b.x, nloc, nx); b.st[0] = nloc; b.st[1] = nx; }
        const unsigned old = xb_add(&bar[XB_XSUB(b.x)], 1u);
        const unsigned gen = old / nloc;
        if (old + 1u == (gen + 1u) * nloc) {
            __builtin_amdgcn_fence(__ATOMIC_RELEASE, "agent");
            asm volatile("s_waitcnt vmcnt(0)" ::: "memory");
            const unsigned og = xb_add(&bar[XB_TOP], 1u);
            const unsigned tg = og / nx;
            if (og + 1u == (tg + 1u) * nx) xb_add(&bar[XB_TOPGEN], 1u);
            else XB_SPIN(xb_ld(&bar[XB_TOPGEN]) == tg, bar);
            __builtin_amdgcn_fence(__ATOMIC_ACQUIRE, "agent");
            xb_add(&bar[XB_XGEN(b.x)], 1u);
            asm volatile("s_waitcnt vmcnt(0)" ::: "memory");
        } else {
            XB_SPIN(xb_ld(&bar[XB_XGEN(b.x)]) == gen, bar);
            __builtin_amdgcn_fence(__ATOMIC_ACQUIRE, "agent");
            asm volatile("s_waitcnt vmcnt(0)" ::: "memory");
        }
    }
    __syncthreads();
}

struct Args { const float* in[17]; float* out; unsigned char* ws; float inv_freq[32]; int mask; int alt; };

__device__ __forceinline__ void p0_prologue(const Args& a, LAS unsigned char* lds, int bid, int G) {
    const int tid = threadIdx.x, lane = tid & 63, wave = tid >> 6;
    LAS float* scr = (LAS float*)(lds + wave * 16384);
    const int gw = bid * 8 + wave, NGW = G * 8;
    unsigned char* ws = a.ws;
    constexpr int I0 = (1024 / 64) * (6144 / 32), I1 = (2048 / 64) * (1024 / 32), I2 = (1024 / 64) * (2048 / 32), I3 = (1024 / 64) * (256 / 32), I4 = (1024 / 64) * (1024 / 32);
    constexpr int NITEMS = I0 + I1 + I2 + I3 + I4;
    for (int it = gw; it < NITEMS; it += NGW) {
        int r = it;
        if (r < I0) { p0_transpose_item(a.in[2], 1024, 6144, (bf16*)(ws + WS_WIN), a.in[1], 0, scr, r, lane); continue; } r -= I0;
        if (r < I1) { p0_transpose_item(a.in[7], 2048, 1024, (bf16*)(ws + WS_WOA), nullptr, 1, scr, r, lane); continue; } r -= I1;
        if (r < I2) { p0_transpose_item(a.in[12], 1024, 2048, (bf16*)(ws + WS_WCAT), a.in[11], 2, scr, r, lane); continue; } r -= I2;
        if (r < I3) { p0_transpose_item(a.in[9], 1024, 256, (bf16*)(ws + WS_WCAT), a.in[8], 3, scr, r, lane); continue; } r -= I3;
        p0_transpose_item(a.in[15], 1024, 1024, (bf16*)(ws + WS_WOB), nullptr, 4, scr, r, lane);
    }
    const float* x = a.in[0]; bf16* XN = (bf16*)(ws + WS_XN);
    for (int m0 = gw * 4; m0 < M; m0 += NGW * 4) {
        f32x4 v[4][4]; float s2[4];
#pragma unroll
        for (int r = 0; r < 4; ++r) { const f32x4* xr = (const f32x4*)(x + (size_t)(m0 + r) * DM) + lane;
#pragma unroll
            for (int j = 0; j < 4; ++j) v[r][j] = xr[64 * j]; }
#pragma unroll
        for (int r = 0; r < 4; ++r) { s2[r] = 0.f;
#pragma unroll
            for (int j = 0; j < 4; ++j) s2[r] += (v[r][j][0] * v[r][j][0] + v[r][j][1] * v[r][j][1]) + (v[r][j][2] * v[r][j][2] + v[r][j][3] * v[r][j][3]); }
#pragma unroll
        for (int o = 1; o < 64; o <<= 1) {
#pragma unroll
            for (int r = 0; r < 4; ++r) s2[r] += __shfl_xor(s2[r], o); }
#pragma unroll
        for (int r = 0; r < 4; ++r) { const float rstd = 1.0f / sqrtf(s2[r] * (1.0f / DM) + EPS);
            u32x2* o8 = (u32x2*)(XN + (size_t)(m0 + r) * DM) + lane;
#pragma unroll
            for (int j = 0; j < 4; ++j) { u32x2 w; w.x = pk2(v[r][j][0] * rstd, v[r][j][1] * rstd); w.y = pk2(v[r][j][2] * rstd, v[r][j][3] * rstd); o8[64 * j] = w; } }
    }
    const int gt = bid * 512 + tid, NGT = G * 512;
    { const float* wsf = a.in[5]; bf16* wsm = (bf16*)(ws + WS_WSM);
      for (int e = gt; e < 16 * 128 * 128 / 2; e += NGT) { const int idx = 2 * e, s = idx & 127, t = (idx >> 7) & 127;
          const f32x2 w = *(const f32x2*)(wsf + idx); *(unsigned*)(wsm + idx) = pk2(s <= t ? w[0] : 0.f, (s + 1) <= t ? w[1] : 0.f); } }
    { float* rot = (float*)(ws + WS_ROT);
      for (int e = gt; e < SEQ * 32; e += NGT) { const int pos = e >> 5, i = e & 31;
          float inv = 0.f;
#pragma unroll
          for (int k = 0; k < 32; ++k) if (i == k) inv = a.inv_freq[k];
          const float ang = (float)pos * inv;
          const double rev = (double)ang * 0.15915494309189535; const float fr = (float)(rev - rint(rev));
          f32x2 cs; cs[0] = __builtin_amdgcn_cosf(fr); cs[1] = __builtin_amdgcn_sinf(fr); *(f32x2*)(rot + (size_t)e * 2) = cs; } }
}

__device__ __forceinline__ void spatial_phase(LAS unsigned char* lds, const bf16* Z, const float* st1, const bf16* wsm, const float* ln_g, const float* ln_b, const float* bs, bf16* Y, int bid, int G) {
    const int tid = threadIdx.x, lane = tid & 63, wid = tid >> 6, fr = lane & 15, fq = lane >> 4;
    constexpr int VS = 136;
    LAS bf16* vnT = (LAS bf16*)lds;
    LAS f32x2* stat = (LAS f32x2*)(lds + 128 * VS * 2);
    const int dw = wid & 1, tw = wid >> 1;
    for (int unit = bid; unit < 2048; unit += G) {
        const int c = unit >> 4, g = unit & 15, row0 = c * 128, ch0 = g * 128;
        if (tid < 128) {
            const f32x4* p = (const f32x4*)(st1 + (size_t)(row0 + tid) * 64);
            float s = 0.f, q = 0.f;
#pragma unroll
            for (int i = 0; i < 16; ++i) { const f32x4 v = p[i]; s += v[0] + v[2]; q += v[1] + v[3]; }
            const float mean = s * (1.0f / AW), var = q * (1.0f / AW) - mean * mean;
            f32x2 o; o[0] = mean; o[1] = 1.0f / sqrtf(var + EPS); stat[tid] = o;
        }
        __syncthreads();
#pragma unroll
        for (int k = 0; k < 2; ++k) {
            const int it = tid + 512 * k, a2 = (it >> 4) * 2, cg8 = (it & 15) * 8;
            const bf16* p0 = Z + (size_t)(row0 + a2) * NZ + AW + ch0 + cg8;
            const u32x4 r0 = *(const u32x4*)p0, r1 = *(const u32x4*)(p0 + NZ);
            const f32x2 s0 = stat[a2], s1 = stat[a2 + 1];
            const f32x4 g0 = *(const f32x4*)(ln_g + ch0 + cg8), g1 = *(const f32x4*)(ln_g + ch0 + cg8 + 4);
            const f32x4 b0 = *(const f32x4*)(ln_b + ch0 + cg8), b1 = *(const f32x4*)(ln_b + ch0 + cg8 + 4);
#pragma unroll
            for (int e = 0; e < 8; ++e) {
                const unsigned w0 = r0[e >> 1], w1 = r1[e >> 1];
                const float v0 = (e & 1) ? bfhi(w0) : bflo(w0), v1 = (e & 1) ? bfhi(w1) : bflo(w1);
                const float gg = e < 4 ? g0[e & 3] : g1[e & 3], bb = e < 4 ? b0[e & 3] : b1[e & 3];
                const float n0 = (v0 - s0[0]) * s0[1] * gg + bb, n1 = (v1 - s1[0]) * s1[1] * gg + bb;
                *(LAS unsigned*)(vnT + (cg8 + e) * VS + a2) = pk2(n0, n1);
            }
        }
        __syncthreads();
        f32x4 acc[4][2];
#pragma unroll
        for (int m = 0; m < 4; ++m)
#pragma unroll
            for (int n = 0; n < 2; ++n) acc[m][n] = (f32x4){0.f, 0.f, 0.f, 0.f};
        for (int ks = 0; ks <= tw; ++ks) {
            bf16x8 A[4], B[2];
#pragma unroll
            for (int m = 0; m < 4; ++m) A[m] = *(const LAS bf16x8*)(vnT + (64 * dw + 16 * m + fr) * VS + 32 * ks + 8 * fq);
#pragma unroll
            for (int n = 0; n < 2; ++n) B[n] = *(const bf16x8*)(wsm + ((size_t)g * 128 + 32 * tw + 16 * n + fr) * 128 + 32 * ks + 8 * fq);
#pragma unroll
            for (int m = 0; m < 4; ++m)
#pragma unroll
                for (int n = 0; n < 2; ++n) acc[m][n] = __builtin_amdgcn_mfma_f32_16x16x32_bf16(A[m], B[n], acc[m][n], 0, 0, 0);
        }
#pragma unroll
        for (int n = 0; n < 2; ++n) { const int t = 32 * tw + 16 * n + fr; const size_t row = (size_t)(row0 + t); const float bias = bs[g * 128 + t];
#pragma unroll
            for (int m = 0; m < 4; ++m) { const int col = ch0 + 64 * dw + 16 * m + 4 * fq;
                const u32x2 uu = *(const u32x2*)(Z + row * NZ + col), gt = *(const u32x2*)(Z + row * NZ + 2 * AW + col);
                const f32x4 sv = acc[m][n] + bias;
                const float y0 = bflo(uu.x) * sv[0] * silu(bflo(gt.x)), y1 = bfhi(uu.x) * sv[1] * silu(bfhi(gt.x));
                const float y2 = bflo(uu.y) * sv[2] * silu(bflo(gt.y)), y3 = bfhi(uu.y) * sv[3] * silu(bfhi(gt.y));
                u32x2 w; w.x = pk2(y0, y1); w.y = pk2(y2, y3); *(u32x2*)(Y + row * AW + col) = w; } }
        __syncthreads();
    }
}

__device__ __forceinline__ int crow(int r, int hi) { return (r & 3) + 8 * (r >> 2) + 4 * hi; }
__device__ __forceinline__ void attn_phase(LAS unsigned char* lds, const bf16* Q, const bf16* Gt, const bf16* Kb, const bf16* Vb, const float* sinks, bf16* Y2, int bid, int G) {
    const int tid = threadIdx.x, lane = tid & 63, wid = tid >> 6, q31 = lane & 31, hi = lane >> 5;
    constexpr int KS = 72, VS = 264;
    LAS bf16* Ks = (LAS bf16*)lds;
    LAS bf16* Vt = (LAS bf16*)(lds + 256 * KS * 2);
    const float NEG = -INFINITY;
    for (int unit = bid; unit < 256; unit += G) {
        const int kvh = unit & 1, n = (unit >> 1) & 31, b = unit >> 6;
        const int row0 = b * SEQ + n * 128;
#pragma unroll
        for (int k = 0; k < 4; ++k) { const int idx = tid + 512 * k, r = idx >> 3, c8 = (idx & 7) * 8;
            u32x4 v = (u32x4){0u, 0u, 0u, 0u};
            if (n > 0 || r >= 128) v = *(const u32x4*)(Kb + (size_t)(row0 - 128 + r) * 128 + kvh * 64 + c8);
            *(LAS u32x4*)(Ks + r * KS + c8) = v; }
#pragma unroll
        for (int k = 0; k < 2; ++k) { const int it = tid + 512 * k, a2 = (it >> 3) * 2, d8 = (it & 7) * 8;
            u32x4 r0 = (u32x4){0u, 0u, 0u, 0u}, r1 = r0;
            if (n > 0 || a2 >= 128) { const bf16* p = Vb + (size_t)(row0 - 128 + a2) * 128 + kvh * 64 + d8; r0 = *(const u32x4*)p; r1 = *(const u32x4*)(p + 128); }
#pragma unroll
            for (int e = 0; e < 8; ++e) { const unsigned w0 = r0[e >> 1], w1 = r1[e >> 1];
                const unsigned lo = (e & 1) ? (w0 >> 16) : (w0 & 0xffffu), hh = (e & 1) ? (w1 & 0xffff0000u) : (w1 << 16);
                *(LAS unsigned*)(Vt + (d8 + e) * VS + a2) = lo | hh; } }
        __syncthreads();
        const int hq = kvh * 8 + wid; const float sink2 = sinks[hq] * LOG2E;
#pragma unroll 1
        for (int qb = 0; qb < 4; ++qb) {
            const size_t grow = (size_t)(row0 + 32 * qb + q31);
            bf16x8 qf[4];
#pragma unroll
            for (int d0 = 0; d0 < 4; ++d0) qf[d0] = *(const bf16x8*)(Q + grow * 1024 + hq * 64 + 16 * d0 + 8 * hi);
            f32x16 s[5];
#pragma unroll
            for (int i = 0; i < 5; ++i) {
#pragma unroll
                for (int r = 0; r < 16; ++r) s[i][r] = 0.f;
#pragma unroll
                for (int d0 = 0; d0 < 4; ++d0) { const bf16x8 kf = *(const LAS bf16x8*)(Ks + (32 * (qb + i) + q31) * KS + 16 * d0 + 8 * hi);
                    s[i] = __builtin_amdgcn_mfma_f32_32x32x16_bf16(kf, qf[d0], s[i], 0, 0, 0); } }
#pragma unroll
            for (int r = 0; r < 16; ++r) { const int cr = crow(r, hi); if (!(cr > q31)) s[0][r] = NEG; if (cr > q31) s[4][r] = NEG; }
            if (n == 0) {
#pragma unroll
                for (int i = 0; i < 4; ++i) if (qb + i < 4) {
#pragma unroll
                    for (int r = 0; r < 16; ++r) s[i][r] = NEG; } }
            float mx = sink2;
#pragma unroll
            for (int i = 0; i < 5; ++i)
#pragma unroll
                for (int r = 0; r < 16; ++r) mx = fmaxf(mx, s[i][r]);
            mx = fmaxf(mx, __shfl_xor(mx, 32));
            float sum = 0.f;
#pragma unroll
            for (int i = 0; i < 5; ++i)
#pragma unroll
                for (int r = 0; r < 16; ++r) { const float p = __builtin_amdgcn_exp2f(s[i][r] - mx); s[i][r] = p; sum += p; }
            sum += __shfl_xor(sum, 32);
            const float inv = 1.0f / (sum + __builtin_amdgcn_exp2f(sink2 - mx));
            f32x16 o[2];
#pragma unroll
            for (int r = 0; r < 16; ++r) { o[0][r] = 0.f; o[1][r] = 0.f; }
#pragma unroll
            for (int i = 0; i < 5; ++i)
#pragma unroll
                for (int sl = 0; sl < 2; ++sl) {
                    u32x4 pw; pw.x = pk2(s[i][8 * sl + 0], s[i][8 * sl + 1]); pw.y = pk2(s[i][8 * sl + 2], s[i][8 * sl + 3]); pw.z = pk2(s[i][8 * sl + 4], s[i][8 * sl + 5]); pw.w = pk2(s[i][8 * sl + 6], s[i][8 * sl + 7]);
                    const bf16x8 pf = __builtin_bit_cast(bf16x8, pw);
#pragma unroll
                    for (int dh = 0; dh < 2; ++dh) { const LAS bf16* vb = Vt + (32 * dh + q31) * VS + 32 * (qb + i) + 16 * sl + 4 * hi;
                        const s16x4 lo = *(const LAS s16x4*)vb, h4 = *(const LAS s16x4*)(vb + 8);
                        const bf16x8 vf = (bf16x8){lo[0], lo[1], lo[2], lo[3], h4[0], h4[1], h4[2], h4[3]};
                        o[dh] = __builtin_amdgcn_mfma_f32_32x32x16_bf16(vf, pf, o[dh], 0, 0, 0); } }
#pragma unroll
            for (int dh = 0; dh < 2; ++dh)
#pragma unroll
                for (int rg = 0; rg < 4; ++rg) { const size_t off = grow * 1024 + hq * 64 + 32 * dh + 8 * rg + 4 * hi;
                    const u32x2 gt = *(const u32x2*)(Gt + off);
                    const float y0 = o[dh][4 * rg + 0] * inv * silu(bflo(gt.x)), y1 = o[dh][4 * rg + 1] * inv * silu(bfhi(gt.x));
                    const float y2 = o[dh][4 * rg + 2] * inv * silu(bflo(gt.y)), y3 = o[dh][4 * rg + 3] * inv * silu(bfhi(gt.y));
                    u32x2 w; w.x = pk2(y0, y1); w.y = pk2(y2, y3); *(u32x2*)(Y2 + off) = w; }
        }
        __syncthreads();
    }
}

__global__ void __launch_bounds__(512, 2) yoco_fwd(Args a) {
    extern __shared__ __attribute__((aligned(16))) unsigned char lds_raw[];
    LAS unsigned char* lds = (LAS unsigned char*)lds_raw;
    const int bid = blockIdx.x, G = gridDim.x;
    unsigned char* ws = a.ws;
    volatile LAS unsigned* MISC = (volatile LAS unsigned*)(lds + 131072);
    if (threadIdx.x < 4) MISC[threadIdx.x] = 0u;
    __syncthreads();
    XcdBarrier bar = xcd_barrier_post((unsigned*)ws, MISC);
    if (a.mask == 0x40000000) { cg::grid_group grid = cg::this_grid(); grid.sync(); }
    float* OUT = a.alt ? (float*)(ws + WS_Q) : a.out;
    bf16* Ybuf = (bf16*)OUT;

    if (a.mask & 1) p0_prologue(a, lds, bid, G);
    if (a.mask & 256) xcd_barrier(bar);

    if (a.mask & 2) {
        pg8::Gemm g{(const bf16*)(ws + WS_XN), (const bf16*)(ws + WS_WIN), M, NZ, DM}; pg8::StaticOrder S; S.init(M, NZ, G, bid);
        pg8::EpiZ E{(bf16*)(ws + WS_Z), (float*)(ws + WS_ST1)};
        pg8::gemm_phase<pg8::EpiZ, pg8::StaticOrder, true, true>(lds, g, S, E);
    }
    if (a.mask & 256) xcd_barrier(bar);

    if (a.mask & 4) spatial_phase(lds, (const bf16*)(ws + WS_Z), (const float*)(ws + WS_ST1), (const bf16*)(ws + WS_WSM), a.in[3], a.in[4], a.in[6], Ybuf, bid, G);
    if (a.mask & 256) xcd_barrier(bar);

    if (a.mask & 8) {
        pg8::Gemm g{Ybuf, (const bf16*)(ws + WS_WOA), M, DM, AW}; pg8::StaticOrder S; S.init(M, DM, G, bid);
        pg8::EpiRes E{a.in[0], (float*)(ws + WS_H), (bf16*)(ws + WS_HB), (float*)(ws + WS_ST2)};
        pg8::gemm_phase<pg8::EpiRes, pg8::StaticOrder, true, true>(lds, g, S, E);
    }
    if (a.mask & 256) xcd_barrier(bar);

    if (a.mask & 16) {
        pg8::Gemm g{(const bf16*)(ws + WS_HB), (const bf16*)(ws + WS_WCAT), M, NQKV, DM}; pg8::StaticOrder S; S.init(M, NQKV, G, bid);
        pg8::EpiQKV E{(const float*)(ws + WS_ST2), (const float*)(ws + WS_ROT), a.in[13], a.in[10], (bf16*)(ws + WS_Q), (bf16*)(ws + WS_G), (bf16*)(ws + WS_K), (bf16*)(ws + WS_V)};
        pg8::gemm_phase<pg8::EpiQKV, pg8::StaticOrder, true, true>(lds, g, S, E);
    }
    if (a.mask & 256) xcd_barrier(bar);

    if (a.mask & 32) attn_phase(lds, (const bf16*)(ws + WS_Q), (const bf16*)(ws + WS_G), (const bf16*)(ws + WS_K), (const bf16*)(ws + WS_V), a.in[14], (bf16*)(ws + WS_Y2), bid, G);
    if (a.mask & 256) xcd_barrier(bar);

    if (a.mask & 64) {
        pg8::Gemm g{(const bf16*)(ws + WS_Y2), (const bf16*)(ws + WS_WOB), M, DM, DM}; pg8::StaticOrder S; S.init(M, DM, G, bid);
        pg8::EpiRes E{(const float*)(ws + WS_H), OUT, nullptr, (float*)(ws + WS_ST3)};
        pg8::gemm_phase<pg8::EpiRes, pg8::StaticOrder, true, true>(lds, g, S, E);
    }
    if (a.mask & 256) xcd_barrier(bar);

    if (a.mask & 128) {
        const int lane = threadIdx.x & 63, gw = bid * 8 + (threadIdx.x >> 6), NGW = G * 8;
        const float* st3 = (const float*)(ws + WS_ST3); const f32x4* gp = (const f32x4*)a.in[16] + lane;
        f32x4 gv[4];
#pragma unroll
        for (int j = 0; j < 4; ++j) gv[j] = gp[64 * j];
        for (int m = gw; m < M; m += NGW) {
            const f32x4* p = (const f32x4*)(st3 + (size_t)m * 16); const f32x4 s4 = (p[0] + p[1]) + (p[2] + p[3]);
            const float rstd = 1.0f / sqrtf(((s4[0] + s4[1]) + (s4[2] + s4[3])) * (1.0f / DM) + EPS);
            const f32x4* xr = (const f32x4*)(a.out + (size_t)m * DM) + lane; f32x4* xo = (f32x4*)(OUT + (size_t)m * DM) + lane;
#pragma unroll
            for (int j = 0; j < 4; ++j) xo[64 * j] = xr[64 * j] * rstd * gv[j];
        }
    }
}

extern "C" void kernel_launch(void* const* d_in, const int* in_sizes, int n_in, void* d_out, int out_size, void* d_ws, size_t ws_size, hipStream_t stream) {
    static int grid = 0;
    if (grid == 0) {
        if (n_in != 17 || in_sizes[0] != M * DM || out_size != M * DM || ws_size < WS_END) { fprintf(stderr, "kernel_launch: unexpected shapes (n_in %d, in0 %d, out %d, ws %zu)\n", n_in, n_in > 0 ? in_sizes[0] : -1, out_size, ws_size); grid = -1; return; }
        int dev = 0, cus = 0, per_cu = 0;
        hipGetDevice(&dev); hipDeviceGetAttribute(&cus, hipDeviceAttributeMultiprocessorCount, dev);
        hipFuncSetAttribute((const void*)yoco_fwd, hipFuncAttributeMaxDynamicSharedMemorySize, LDS_BYTES);
        hipOccupancyMaxActiveBlocksPerMultiprocessor(&per_cu, (const void*)yoco_fwd, 512, LDS_BYTES);
        (void)hipGetLastError();
        if (per_cu < 1) per_cu = 1;
        grid = cus * 1;
        if (grid <= 0) grid = 256;
    }
    if (grid < 0) return;
    Args a{};
    for (int i = 0; i < 17; ++i) a.in[i] = (const float*)d_in[i];
    a.out = (float*)d_out; a.ws = (unsigned char*)d_ws;
    for (int i = 0; i < 32; ++i) a.inv_freq[i] = powf(10000.0f, -(float)(2 * i) / 64.0f);
    a.mask = 0x1ff; a.alt = 0;
    (void)hipMemsetAsync(d_ws, 0, 16384, stream);
    void* args[] = {&a};
    hipError_t e = hipLaunchCooperativeKernel((const void*)yoco_fwd, dim3(grid), dim3(512), args, LDS_BYTES, stream);
    if (e != hipSuccess) fprintf(stderr, "cooperative launch failed: %s (grid %d)\n", hipGetErrorString(e), grid);
#ifdef PROBE_MASK
    a.mask = PROBE_MASK; a.alt = 1;
    (void)hipMemsetAsync(d_ws, 0, 16384, stream);
    e = hipLaunchCooperativeKernel((const void*)yoco_fwd, dim3(grid), dim3(512), args, LDS_BYTES, stream);
#endif
}
```

```cpp
#include <hip/hip_runtime.h>
#include <hip/hip_cooperative_groups.h>
#include <cstdio>
#include <cstdint>
#include <cmath>
namespace cg = cooperative_groups;
namespace pg8 {
#define PG8_LAS __attribute__((address_space(3)))
typedef unsigned short bf16_t;
typedef short bf16x8 __attribute__((ext_vector_type(8)));
typedef float f32x4 __attribute__((ext_vector_type(4)));
typedef unsigned u32x4 __attribute__((ext_vector_type(4)));
constexpr int BM = 256, BK = 64, HALF = 128, HTB = HALF * BK * 2  , STAGE_BYTES = 8 * HTB, NXCD = 8, WGM = 8;

__host__ __device__ __forceinline__ int lds_byte(int r, int c) { const int st = (r >> 4) * 2 + (c >> 5), rr = r & 15, cc = c & 31, ob = rr * 64 + cc * 2; return st * 1024 + (ob ^ (((ob >> 9) & 1) << 5)); }
__host__ __device__ __forceinline__ void stage_rc(int b, int& R, int& C) { const int st = b / 1024, sb = b % 1024, swz = sb ^ (((sb >> 9) & 1) << 5); R = (st >> 1) * 16 + swz / 64; C = (st & 1) * 32 + (swz % 64) / 2; }
__host__ __device__ __forceinline__ int perm32(int rho) { const int n = rho >> 4, i = rho & 15; return 8 * (i >> 2) + 4 * n + (i & 3); }

struct Unit { int pm, pn; };
struct Gemm { const bf16_t* A; const bf16_t* Bt; int M, N, K; };

struct StaticOrder {
    int nM, nN, nwg, G, c;
    __host__ __device__ void init(int M, int N, int G_, int c_) { nM = M / BM; nN = N / BM; nwg = nM * nN; G = G_; c = c_; }
    __host__ __device__ bool next(int i, Unit& u) const {
        const long L = (long)i * G + c; if (L >= nwg) return false;
        int wgid = (int)L; { const int q = nwg / NXCD, r = nwg % NXCD, xcd = wgid % NXCD, off = wgid / NXCD; wgid = (xcd < r ? xcd * (q + 1) : r * (q + 1) + (xcd - r) * q) + off; }
        const int nig = WGM * nN, gid = wgid / nig, fm = gid * WGM, gsz = (nM - fm) < WGM ? (nM - fm) : WGM;
        u.pm = fm + ((wgid % nig) % gsz); u.pn = (wgid % nig) / gsz; return true;
    }
    __device__ __forceinline__ void a_ready(const Unit&) const {}
    __device__ __forceinline__ void done(const Unit&) const {}
};

__device__ __forceinline__ unsigned cvt_pk_bf16(float lo, float hi) { unsigned r; asm volatile("v_cvt_pk_bf16_f32 %0, %1, %2" : "=v"(r) : "v"(lo), "v"(hi)); return r; }
typedef float f32x2 __attribute__((ext_vector_type(2)));
typedef unsigned u32x2 __attribute__((ext_vector_type(2)));
__device__ __forceinline__ unsigned pkbf(float lo, float hi) { unsigned r; asm("v_cvt_pk_bf16_f32 %0, %1, %2" : "=v"(r) : "v"(lo), "v"(hi)); return r; }
constexpr float RMS_EPS = 1e-5f;

struct EpiZ {
    static constexpr bool PERM = true, AFTER_DRAIN = false;
    bf16_t* Z; float* st;
    __device__ __forceinline__ void operator()(const f32x4 (&acc)[2][2][4][2], const Unit& u, int wr, int wc, int fr, int fq) const {
        const int row0 = u.pm * BM + wr * 64 + fr, col0 = u.pn * BM + wc * 32 + 8 * fq;
        const bool isv = (u.pn >= 8 && u.pn < 16);
#pragma unroll
        for (int ai = 0; ai < 2; ++ai)
#pragma unroll
            for (int m = 0; m < 4; ++m) { const int row = row0 + ai * HALF + m * 16; bf16_t* rowp = Z + (size_t)row * 6144 + col0;
                float s = 0.f, q = 0.f;
#pragma unroll
                for (int bj = 0; bj < 2; ++bj) { const f32x4 v0 = acc[ai][bj][m][0], v1 = acc[ai][bj][m][1];
                    u32x4 w; w.x = pkbf(v0[0], v0[1]); w.y = pkbf(v0[2], v0[3]); w.z = pkbf(v1[0], v1[1]); w.w = pkbf(v1[2], v1[3]);
                    *(u32x4*)(rowp + bj * HALF) = w;
                    s += (v0[0] + v0[1]) + (v0[2] + v0[3]) + (v1[0] + v1[1]) + (v1[2] + v1[3]);
                    q += (v0[0] * v0[0] + v0[1] * v0[1]) + (v0[2] * v0[2] + v0[3] * v0[3]) + (v1[0] * v1[0] + v1[1] * v1[1]) + (v1[2] * v1[2] + v1[3] * v1[3]); }
                if (isv) { s += __shfl_xor(s, 16); s += __shfl_xor(s, 32); q += __shfl_xor(q, 16); q += __shfl_xor(q, 32);
                    if (fq == 0) { f32x2 o; o.x = s; o.y = q; *(f32x2*)(st + ((size_t)row * 32 + (u.pn - 8) * 4 + wc) * 2) = o; } }
            }
    }
};

struct EpiRes {
    static constexpr bool PERM = false, AFTER_DRAIN = false;
    const float* base; float* out; bf16_t* outb; float* st;
    __device__ __forceinline__ void operator()(const f32x4 (&acc)[2][2][4][2], const Unit& u, int wr, int wc, int fr, int fq) const {
        const int row0 = u.pm * BM + wr * 64 + fr, col0 = u.pn * BM + wc * 32 + 4 * fq;
#pragma unroll
        for (int ai = 0; ai < 2; ++ai)
#pragma unroll
            for (int m = 0; m < 4; ++m) { const int row = row0 + ai * HALF + m * 16; const size_t off = (size_t)row * 1024 + col0; float q = 0.f;
#pragma unroll
                for (int bj = 0; bj < 2; ++bj)
#pragma unroll
                    for (int n = 0; n < 2; ++n) { const f32x4 b = *(const f32x4*)(base + off + bj * HALF + n * 16); const f32x4 h = b + acc[ai][bj][m][n];
                        *(f32x4*)(out + off + bj * HALF + n * 16) = h;
                        if (outb) { u32x2 w; w.x = pkbf(h[0], h[1]); w.y = pkbf(h[2], h[3]); *(u32x2*)(outb + off + bj * HALF + n * 16) = w; }
                        q += (h[0] * h[0] + h[1] * h[1]) + (h[2] * h[2] + h[3] * h[3]); }
                q += __shfl_xor(q, 16); q += __shfl_xor(q, 32);
                if (fq == 0) st[(size_t)row * 16 + u.pn * 4 + wc] = q;
            }
    }
};

struct EpiQKV {
    static constexpr bool PERM = false, AFTER_DRAIN = false;
    const float* st2; const float* rot; const float* bq; const float* bkv; bf16_t* Q; bf16_t* Gt; bf16_t* Kb; bf16_t* Vb;
    __device__ __forceinline__ void operator()(const f32x4 (&acc)[2][2][4][2], const Unit& u, int wr, int wc, int fr, int fq) const {
        const int row0 = u.pm * BM + wr * 64 + fr;
        float rs[2][4];
#pragma unroll
        for (int ai = 0; ai < 2; ++ai)
#pragma unroll
            for (int m = 0; m < 4; ++m) { const f32x4* p = (const f32x4*)(st2 + (size_t)(row0 + ai * HALF + m * 16) * 16); const f32x4 a = (p[0] + p[1]) + (p[2] + p[3]);
                rs[ai][m] = 1.0f / sqrtf(((a[0] + a[1]) + (a[2] + a[3])) * (1.0f / 1024.0f) + RMS_EPS); }
        if (u.pn >= 4 && u.pn < 8) {
            const int col0 = (u.pn - 4) * BM + wc * 32 + 4 * fq;
#pragma unroll
            for (int ai = 0; ai < 2; ++ai)
#pragma unroll
                for (int m = 0; m < 4; ++m) { const int row = row0 + ai * HALF + m * 16; const float r = rs[ai][m];
#pragma unroll
                    for (int bj = 0; bj < 2; ++bj)
#pragma unroll
                        for (int n = 0; n < 2; ++n) { const f32x4 v = acc[ai][bj][m][n] * r; u32x2 w; w.x = pkbf(v[0], v[1]); w.y = pkbf(v[2], v[3]);
                            *(u32x2*)(Gt + (size_t)row * 1024 + col0 + bj * HALF + n * 16) = w; } }
            return;
        }
        const bool isq = (u.pn < 4);
        const int i0 = (wc & 1) * 16 + 4 * fq;
#pragma unroll
        for (int bj = 0; bj < 2; ++bj) {
            if (!isq && bj == 1) {
                const int col0 = wc * 32 + 4 * fq;
#pragma unroll
                for (int n = 0; n < 2; ++n) { const f32x4 bv = *(const f32x4*)(bkv + 128 + col0 + n * 16);
#pragma unroll
                    for (int ai = 0; ai < 2; ++ai)
#pragma unroll
                        for (int m = 0; m < 4; ++m) { const int row = row0 + ai * HALF + m * 16; const f32x4 v = acc[ai][1][m][n] * rs[ai][m] + bv;
                            u32x2 w; w.x = pkbf(v[0], v[1]); w.y = pkbf(v[2], v[3]); *(u32x2*)(Vb + (size_t)row * 128 + col0 + n * 16) = w; } }
            } else {
                const int head = isq ? (u.pn * 4 + bj * 2 + (wc >> 1)) : (wc >> 1);
                const float* bias = (isq ? bq : bkv) + head * 64 + i0;
                const f32x4 b1 = *(const f32x4*)(bias), b2 = *(const f32x4*)(bias + 32);
                const float sc = isq ? (0.125f * 1.4426950408889634f) : 1.0f;
                bf16_t* dstb = isq ? (Q + head * 64 + i0) : (Kb + head * 64 + i0); const int ldo = isq ? 1024 : 128;
#pragma unroll
                for (int ai = 0; ai < 2; ++ai)
#pragma unroll
                    for (int m = 0; m < 4; ++m) { const int row = row0 + ai * HALF + m * 16; const int pos = row & 4095;
                        const f32x4* rp = (const f32x4*)(rot + ((size_t)pos * 32 + i0) * 2); const f32x4 cs0 = rp[0], cs1 = rp[1];
                        const f32x4 x1 = acc[ai][bj][m][0] * rs[ai][m] + b1, x2 = acc[ai][bj][m][1] * rs[ai][m] + b2;
                        const float c[4] = {cs0[0], cs0[2], cs1[0], cs1[2]}, s[4] = {cs0[1], cs0[3], cs1[1], cs1[3]};
                        float o1[4], o2[4];
#pragma unroll
                        for (int j = 0; j < 4; ++j) { o1[j] = (x1[j] * c[j] - x2[j] * s[j]) * sc; o2[j] = (x2[j] * c[j] + x1[j] * s[j]) * sc; }
                        u32x2 w1, w2; w1.x = pkbf(o1[0], o1[1]); w1.y = pkbf(o1[2], o1[3]); w2.x = pkbf(o2[0], o2[1]); w2.y = pkbf(o2[2], o2[3]);
                        bf16_t* d = dstb + (size_t)row * ldo; *(u32x2*)d = w1; *(u32x2*)(d + 32) = w2; }
            }
        }
    }
};

template <class Epi, class Sched, bool ALIGN_EPI = false, bool SP2 = false>
__device__ __forceinline__ void gemm_phase(PG8_LAS unsigned char* lds, const Gemm g, const Sched& S, const Epi& E) {
    const int tid = threadIdx.x, wid = __builtin_amdgcn_readfirstlane(tid >> 6), lane = tid & 63, wr = wid >> 2, wc = wid & 3, fr = lane & 15, fq = lane >> 4;
    const int K = g.K, nt = K / BK;
    unsigned voffA[2], voffB[2];
#pragma unroll
    for (int i = 0; i < 2; ++i) { int R, C; stage_rc(tid * 16 + i * 8192, R, C); const int Rb = Epi::PERM ? ((R & ~31) + perm32(R & 31)) : R;
        voffA[i] = (unsigned)(R * K + C) * 2u; voffB[i] = (unsigned)(Rb * K + C) * 2u; }
    const size_t kstep = (size_t)(BK * 2);
    const size_t hstep = (size_t)HALF * K * 2;
    const size_t tstep = 2 * hstep;
    const unsigned ldsw = (unsigned)wid * 1024u;
    const int aoff = lds_byte(wr * 64 + fr, fq * 8), boff = lds_byte(wc * 32 + fr, fq * 8);
#define PG8_SA(b, h) (((b) * 2 + (h)) * HTB)
#define PG8_SB(b, h) ((4 + (b) * 2 + (h)) * HTB)
#define PG8_STAGE(bufoff, gbase, voff) do { _Pragma("unroll") for (int _i = 0; _i < 2; ++_i) \
        __builtin_amdgcn_global_load_lds((const unsigned*)((const char*)(gbase) + (voff)[_i]), (PG8_LAS unsigned*)(lds + (bufoff) + ldsw + _i * 8192), 16, 0, 0); } while (0)
#define PG8_LDA(dst, b, h) do { _Pragma("unroll") for (int m = 0; m < 4; ++m) _Pragma("unroll") for (int k = 0; k < 2; ++k) dst[m][k] = *(const PG8_LAS bf16x8*)(lds + PG8_SA(b, h) + aoff + m * 2048 + k * 1024); } while (0)
#define PG8_LDB(dst, b, h) do { _Pragma("unroll") for (int n = 0; n < 2; ++n) _Pragma("unroll") for (int k = 0; k < 2; ++k) dst[n][k] = *(const PG8_LAS bf16x8*)(lds + PG8_SB(b, h) + boff + n * 2048 + k * 1024); } while (0)
#define PG8_MMA(ai, bj, At, Bt) do { __builtin_amdgcn_s_setprio(1); _Pragma("unroll") for (int m = 0; m < 4; ++m) _Pragma("unroll") for (int n = 0; n < 2; ++n) _Pragma("unroll") for (int k = 0; k < 2; ++k) \
        acc[ai][bj][m][n] = __builtin_amdgcn_mfma_f32_16x16x32_bf16(Bt[n][k], At[m][k], acc[ai][bj][m][n], 0, 0, 0); __builtin_amdgcn_s_setprio(0); } while (0)
#define PG8_WAIT_V(n) asm volatile("s_waitcnt vmcnt(" #n ")" ::: "memory")
#define PG8_WAIT_L(n) asm volatile("s_waitcnt lgkmcnt(" #n ")" ::: "memory")
#define PG8_BAR __builtin_amdgcn_s_barrier()
#define PG8_SCHED __builtin_amdgcn_sched_barrier(0)
    Unit cur, nxt; int ui = 0;
    if (!S.next(0, cur)) return;
    f32x4 acc[2][2][4][2];
#pragma unroll
    for (int a = 0; a < 2; ++a)
#pragma unroll
        for (int b = 0; b < 2; ++b)
#pragma unroll
            for (int m = 0; m < 4; ++m)
#pragma unroll
                for (int n = 0; n < 2; ++n) acc[a][b][m][n] = (f32x4){0.f, 0.f, 0.f, 0.f};
    bf16x8 At[4][2], B0[2][2], B1[2][2];
    const char* cA = (const char*)g.A + (size_t)cur.pm * tstep; const char* cB = (const char*)g.Bt + (size_t)cur.pn * tstep;
    S.a_ready(cur);
    if constexpr (SP2) {
        PG8_STAGE(PG8_SB(0, 0), cB, voffB); PG8_STAGE(PG8_SB(0, 1), cB + hstep, voffB); PG8_STAGE(PG8_SA(0, 0), cA, voffA); PG8_STAGE(PG8_SA(0, 1), cA + hstep, voffA);
        if (wr == 1) PG8_BAR;
        PG8_WAIT_V(2); PG8_BAR;
        PG8_STAGE(PG8_SB(1, 0), cB + kstep, voffB); PG8_STAGE(PG8_SA(1, 0), cA + kstep, voffA); PG8_STAGE(PG8_SB(1, 1), cB + hstep + kstep, voffB);
        PG8_WAIT_V(6); PG8_BAR;
    } else {
        PG8_STAGE(PG8_SB(0, 0), cB, voffB); PG8_STAGE(PG8_SA(0, 0), cA, voffA); PG8_STAGE(PG8_SB(0, 1), cB + hstep, voffB); PG8_STAGE(PG8_SA(0, 1), cA + hstep, voffA);
        if (wr == 1) PG8_BAR;
        PG8_WAIT_V(4); PG8_BAR;
        PG8_STAGE(PG8_SB(1, 0), cB + kstep, voffB); PG8_STAGE(PG8_SA(1, 0), cA + kstep, voffA); PG8_STAGE(PG8_SB(1, 1), cB + hstep + kstep, voffB);
        PG8_WAIT_V(6); PG8_BAR;
    }
    for (;;) {
        const bool has_next = S.next(ui + 1, nxt);
        const char* nA = has_next ? (const char*)g.A + (size_t)nxt.pm * tstep : cA; const char* nB = has_next ? (const char*)g.Bt + (size_t)nxt.pn * tstep : cB;
        for (int t = 0; t < nt; t += 2) {
            const bool last = (t == nt - 2);
            const char* a1 = cA + (size_t)(t + 1) * kstep;
            const char* a2 = last ? nA : cA + (size_t)(t + 2) * kstep; const char* b2 = last ? nB : cB + (size_t)(t + 2) * kstep;
            const char* a3 = a2 + kstep; const char* b3 = b2 + kstep;
            if (last && has_next) S.a_ready(nxt);
            if constexpr (SP2) {
            PG8_LDB(B0, 0, 0); PG8_LDB(B1, 0, 1); PG8_SCHED; PG8_LDA(At, 0, 0); PG8_STAGE(PG8_SA(1, 1), a1 + hstep, voffA);
            PG8_WAIT_V(8); PG8_WAIT_L(0); PG8_BAR; PG8_MMA(0, 0, At, B0); PG8_MMA(0, 1, At, B1); PG8_BAR; PG8_SCHED;
            PG8_LDA(At, 0, 1); PG8_STAGE(PG8_SB(0, 0), b2, voffB); PG8_STAGE(PG8_SB(0, 1), b2 + hstep, voffB); PG8_STAGE(PG8_SA(0, 0), a2, voffA);
            PG8_WAIT_V(8); PG8_WAIT_L(0); PG8_BAR; PG8_MMA(1, 0, At, B0); PG8_MMA(1, 1, At, B1); PG8_BAR; PG8_SCHED;
            PG8_LDB(B0, 1, 0); PG8_LDB(B1, 1, 1); PG8_SCHED; PG8_LDA(At, 1, 0); PG8_STAGE(PG8_SA(0, 1), a2 + hstep, voffA);
            PG8_WAIT_V(8); PG8_WAIT_L(0); PG8_BAR; PG8_MMA(0, 0, At, B0); PG8_MMA(0, 1, At, B1); PG8_BAR; PG8_SCHED;
            PG8_LDA(At, 1, 1); PG8_STAGE(PG8_SB(1, 0), b3, voffB); PG8_STAGE(PG8_SB(1, 1), b3 + hstep, voffB); PG8_STAGE(PG8_SA(1, 0), a3, voffA);
            PG8_WAIT_V(8); PG8_WAIT_L(0); PG8_BAR; PG8_MMA(1, 0, At, B0); PG8_MMA(1, 1, At, B1); PG8_BAR; PG8_SCHED;
            } else {
            PG8_LDB(B0, 0, 0); PG8_SCHED; PG8_LDA(At, 0, 0); PG8_STAGE(PG8_SA(1, 1), a1 + hstep, voffA);
            PG8_WAIT_L(8); PG8_BAR; PG8_WAIT_L(0); PG8_MMA(0, 0, At, B0); PG8_BAR; PG8_SCHED;
            PG8_LDB(B1, 0, 1); PG8_STAGE(PG8_SB(0, 0), b2, voffB);
            PG8_BAR; PG8_WAIT_L(0); PG8_MMA(0, 1, At, B1); PG8_BAR;
            PG8_LDA(At, 0, 1); PG8_STAGE(PG8_SA(0, 0), a2, voffA);
            PG8_BAR; PG8_WAIT_L(0); PG8_MMA(1, 0, At, B0); PG8_BAR; PG8_SCHED;
            PG8_STAGE(PG8_SB(0, 1), b2 + hstep, voffB);
            PG8_WAIT_V(6); PG8_BAR; PG8_MMA(1, 1, At, B1); PG8_BAR;
            PG8_LDB(B0, 1, 0); PG8_SCHED; PG8_LDA(At, 1, 0); PG8_STAGE(PG8_SA(0, 1), a2 + hstep, voffA);
            PG8_WAIT_L(8); PG8_BAR; PG8_WAIT_L(0); PG8_MMA(0, 0, At, B0); PG8_BAR; PG8_SCHED;
            PG8_LDB(B1, 1, 1); PG8_STAGE(PG8_SB(1, 0), b3, voffB);
            PG8_BAR; PG8_WAIT_L(0); PG8_MMA(0, 1, At, B1); PG8_BAR;
            PG8_LDA(At, 1, 1); PG8_STAGE(PG8_SA(1, 0), a3, voffA);
            PG8_BAR; PG8_WAIT_L(0); PG8_MMA(1, 0, At, B0); PG8_BAR; PG8_SCHED;
            PG8_STAGE(PG8_SB(1, 1), b3 + hstep, voffB);
            PG8_WAIT_V(6); PG8_BAR; PG8_MMA(1, 1, At, B1); PG8_BAR;
            }
        }
        if constexpr (ALIGN_EPI) { if (wr == 0) PG8_BAR; }
        if constexpr (!Epi::AFTER_DRAIN) { E(acc, cur, wr, wc, fr, fq); S.done(cur); }
        if (!has_next) break;
#pragma unroll
        for (int a = 0; a < 2; ++a)
#pragma unroll
            for (int b = 0; b < 2; ++b)
#pragma unroll
                for (int m = 0; m < 4; ++m)
#pragma unroll
                    for (int n = 0; n < 2; ++n) acc[a][b][m][n] = (f32x4){0.f, 0.f, 0.f, 0.f};
        cur = nxt; cA = nA; cB = nB; ++ui;
        if constexpr (ALIGN_EPI) { if (wr == 1) PG8_BAR; }
    }
    PG8_WAIT_V(0);
    if constexpr (!ALIGN_EPI) { if (wr == 0) PG8_BAR; }
    PG8_BAR;
    if constexpr (Epi::AFTER_DRAIN) { E.fused(acc, cur, wr, wc, fr, fq, lds, wid, lane); S.done(cur); }
#undef PG8_SA
#undef PG8_SB
#undef PG8_STAGE
#undef PG8_LDA
#undef PG8_LDB
#undef PG8_MMA
#undef PG8_WAIT_V
#undef PG8_WAIT_L
#undef PG8_BAR
#undef PG8_SCHED
}
}

constexpr int M = 16384, DM = 1024, SEQ = 4096, AW = 2048, NZ = 6144, NQKV = 2304;
constexpr float EPS = 1e-5f, LOG2E = 1.4426950408889634f;
constexpr size_t MiB = 1u << 20;
constexpr size_t WS_WIN = 1 * MiB;
constexpr size_t WS_WOA = 13 * MiB;
constexpr size_t WS_WCAT = 17 * MiB;
constexpr size_t WS_WOB = 22 * MiB;
constexpr size_t WS_WSM = 24 * MiB;
constexpr size_t WS_ROT = 25 * MiB;
constexpr size_t WS_ST1 = 26 * MiB;
constexpr size_t WS_ST2 = 30 * MiB;
constexpr size_t WS_ST3 = 31 * MiB;
constexpr size_t WS_Z = 32 * MiB;
constexpr size_t WS_XN = 224 * MiB;
constexpr size_t WS_H = 32 * MiB;
constexpr size_t WS_HB = 96 * MiB;
constexpr size_t WS_Q = 128 * MiB;
constexpr size_t WS_G = 160 * MiB;
constexpr size_t WS_K = 192 * MiB;
constexpr size_t WS_V = 196 * MiB;
constexpr size_t WS_Y2 = 224 * MiB;
constexpr size_t WS_END = 256 * MiB;
constexpr int LDS_BYTES = 131072 + 1024;

#define LAS __attribute__((address_space(3)))
typedef unsigned short bf16;
typedef float f32x2 __attribute__((ext_vector_type(2)));
typedef float f32x4 __attribute__((ext_vector_type(4)));
typedef float f32x16 __attribute__((ext_vector_type(16)));
typedef unsigned u32x2 __attribute__((ext_vector_type(2)));
typedef unsigned u32x4 __attribute__((ext_vector_type(4)));
typedef short bf16x8 __attribute__((ext_vector_type(8)));
typedef short s16x4 __attribute__((ext_vector_type(4)));

__device__ __forceinline__ unsigned pk2(float lo, float hi) { return pg8::pkbf(lo, hi); }
__device__ __forceinline__ float bflo(unsigned w) { return __uint_as_float(w << 16); }
__device__ __forceinline__ float bfhi(unsigned w) { return __uint_as_float(w & 0xffff0000u); }
__device__ __forceinline__ float silu(float x) { return x * __builtin_amdgcn_rcpf(1.0f + __builtin_amdgcn_exp2f(-x * LOG2E)); }
__device__ __forceinline__ float wave_sum(float v) {
#pragma unroll
    for (int o = 1; o < 64; o <<= 1) v += __shfl_xor(v, o);
    return v;
}

__device__ __forceinline__ int rot_phys(int L) {
    const int hit = (L >> 6) & 3, d = L & 63, n = d >> 5, i = d & 31, wlo = i >> 4, i16 = i & 15;
    const int bj = hit >> 1, wc = (hit & 1) * 2 + wlo;
    return 128 * bj + 32 * wc + 16 * n + i16;
}
__device__ __forceinline__ int wrow(int mode, int n) {
    if (mode == 2) return n < 1024 ? ((n & ~255) + rot_phys(n & 255)) : n;
    if (mode == 3) return n < 128 ? (2048 + rot_phys(n)) : (2048 + n);
    return n;
}
__device__ __forceinline__ void p0_transpose_item(const float* W, int K, int N, bf16* WT, const float* gain, int mode, LAS float* scr, int item, int lane) {
    const int nblk = N / 32, kb = item / nblk, nb = item % nblk, k0 = 64 * kb, n0 = 32 * nb;
    float wv[32];
#pragma unroll
    for (int i = 0; i < 32; ++i) { const int kk = 2 * i + (lane >> 5); wv[i] = W[(size_t)(k0 + kk) * N + n0 + (lane & 31)]; }
    if (gain) {
#pragma unroll
        for (int i = 0; i < 32; ++i) wv[i] *= gain[k0 + 2 * i + (lane >> 5)]; }
#pragma unroll
    for (int i = 0; i < 32; ++i) { const int kk = 2 * i + (lane >> 5); scr[kk * 33 + (lane & 31)] = wv[i]; }
    asm volatile("s_waitcnt lgkmcnt(0)" ::: "memory");
    const int c = lane & 7;
#pragma unroll
    for (int j = 0; j < 4; ++j) { const int n = (lane >> 3) + 8 * j; const LAS float* s = scr + (8 * c) * 33 + n;
        u32x4 o; o.x = pk2(s[0 * 33], s[1 * 33]); o.y = pk2(s[2 * 33], s[3 * 33]); o.z = pk2(s[4 * 33], s[5 * 33]); o.w = pk2(s[6 * 33], s[7 * 33]);
        *(u32x4*)(WT + (size_t)wrow(mode, n0 + n) * K + k0 + 8 * c) = o; }
    asm volatile("s_waitcnt lgkmcnt(0)" ::: "memory");
}

#define XB_TMO      128
#define XB_XCNT(j)  (256  + 64 * (j))
#define XB_XSUB(j)  (1280 + 64 * (j))
#define XB_XGEN(j)  (2304 + 64 * (j))
#define XB_TOP      3328
#define XB_TOPGEN   3392
#define XCD_BAR_WORDS 3456
#define XB_SPIN_CAP (1u << 18)

__device__ __forceinline__ unsigned xb_ld(unsigned* p)              { return __hip_atomic_load(p, __ATOMIC_RELAXED, __HIP_MEMORY_SCOPE_AGENT); }
__device__ __forceinline__ unsigned xb_add(unsigned* p, unsigned v) { return __hip_atomic_fetch_add(p, v, __ATOMIC_RELAXED, __HIP_MEMORY_SCOPE_AGENT); }
__device__ __forceinline__ unsigned xb_xcc_id() { return (unsigned)__builtin_amdgcn_s_getreg((3 << 11) | 20) & 0xFu; }
#define XB_SPIN(cond, bar) do { unsigned _sp = 0; while (cond) { __builtin_amdgcn_s_sleep(1); \
    if ((++_sp & 255u) == 0u) { if (xb_ld(&(bar)[XB_TMO])) break; if (_sp > XB_SPIN_CAP) { atomicAdd(&(bar)[XB_TMO], 1u); break; } } } } while (0)

struct XcdBarrier {
    unsigned* bar; unsigned x;
    volatile LAS unsigned* st;
};

__device__ __forceinline__ XcdBarrier xcd_barrier_post(unsigned* bar, volatile LAS unsigned* st) {
    XcdBarrier b; b.bar = bar; b.x = xb_xcc_id(); b.st = st;
    if (threadIdx.x == 0) (void)xb_add(&bar[XB_XCNT(b.x)], 1u);
    return b;
}
__device__ __forceinline__ void xcd_barrier_complete(unsigned* bar, unsigned x, unsigned& nloc, unsigned& nx) {
    const unsigned G = gridDim.x * gridDim.y * gridDim.z;
    unsigned sum, cnt, mine, sp = 0u;
    for (;;) {
        sum = 0u; cnt = 0u; mine = 0u;
#pragma unroll
        for (unsigned j = 0; j < 16; ++j) { const unsigned c = xb_ld(&bar[XB_XCNT(j)]); sum += c; cnt += (c > 0u) ? 1u : 0u; mine = (j == x) ? c : mine; }
        if (sum == G) break;
        __builtin_amdgcn_s_sleep(1);
        if ((++sp & 255u) == 0u) { if (xb_ld(&bar[XB_TMO])) break; if (sp > XB_SPIN_CAP) { atomicAdd(&bar[XB_TMO], 1u); break; } }
    }
    nloc = mine > 0u ? mine : 1u; nx = cnt > 0u ? cnt : 1u;
}

__device__ __forceinline__ void xcd_barrier(const XcdBarrier& b) {
    asm volatile("s_waitcnt vmcnt(0)" ::: "memory");
    __syncthreads();
    if (threadIdx.x == 0) {
        unsigned* bar = b.bar;
        __builtin_amdgcn_s_waitcnt(0);
        unsigned nloc = b.st[0], nx = b.st[1];
        if (nloc == 0u) { xcd_barrier_complete(bar, b.x, nloc, nx); b.st[0] = nloc; b.st[1] = nx; }
        const unsigned old = xb_add(&bar[XB_XSUB(b.x)], 1u);
        const unsigned gen = old / nloc;
        if (old + 1u == (gen + 1u) * nloc) {
            __builtin_amdgcn_fence(__ATOMIC_RELEASE, "agent");
            asm volatile("s_waitcnt vmcnt(0)" ::: "memory");
            const unsigned og = xb_add(&bar[XB_TOP], 1u);
            const unsigned tg = og / nx;
            if (og + 1u == (tg + 1u) * nx) xb_add(&bar[XB_TOPGEN], 1u);
            else XB_SPIN(xb_ld(&bar[XB_TOPGEN]) == tg, bar);
            __builtin_amdgcn_fence(__ATOMIC_ACQUIRE, "agent");
            xb_add(&bar[XB_XGEN(b.x)], 1u);
            asm volatile("s_waitcnt vmcnt(0)" ::: "memory");
        } else {
            XB_SPIN(xb_ld(&bar[XB_XGEN(b.x)]) == gen, bar);
            __builtin_amdgcn_fence(__ATOMIC_ACQUIRE, "agent");
            asm volatile("s_waitcnt vmcnt(0)" ::: "memory");
        }
    }
    __syncthreads();
}

struct Args { const float* in[17]; float* out; unsigned char* ws; float inv_freq[32]; int mask; int alt; };

__device__ __forceinline__ void p0_prologue(const Args& a, LAS unsigned char* lds, int bid, int G) {
    const int tid = threadIdx.x, lane = tid & 63, wave = tid >> 6;
    LAS float* scr = (LAS float*)(lds + wave * 16384);
    const int gw = bid * 8 + wave, NGW = G * 8;
    unsigned char* ws = a.ws;
    constexpr int I0 = (1024 / 64) * (6144 / 32), I1 = (2048 / 64) * (1024 / 32), I2 = (1024 / 64) * (2048 / 32), I3 = (1024 / 64) * (256 / 32), I4 = (1024 / 64) * (1024 / 32);
    constexpr int NITEMS = I0 + I1 + I2 + I3 + I4;
    for (int it = gw; it < NITEMS; it += NGW) {
        int r = it;
        if (r < I0) { p0_transpose_item(a.in[2], 1024, 6144, (bf16*)(ws + WS_WIN), a.in[1], 0, scr, r, lane); continue; } r -= I0;
        if (r < I1) { p0_transpose_item(a.in[7], 2048, 1024, (bf16*)(ws + WS_WOA), nullptr, 1, scr, r, lane); continue; } r -= I1;
        if (r < I2) { p0_transpose_item(a.in[12], 1024, 2048, (bf16*)(ws + WS_WCAT), a.in[11], 2, scr, r, lane); continue; } r -= I2;
        if (r < I3) { p0_transpose_item(a.in[9], 1024, 256, (bf16*)(ws + WS_WCAT), a.in[8], 3, scr, r, lane); continue; } r -= I3;
        p0_transpose_item(a.in[15], 1024, 1024, (bf16*)(ws + WS_WOB), nullptr, 4, scr, r, lane);
    }
    const float* x = a.in[0]; bf16* XN = (bf16*)(ws + WS_XN);
    for (int m0 = gw * 4; m0 < M; m0 += NGW * 4) {
        f32x4 v[4][4]; float s2[4];
#pragma unroll
        for (int r = 0; r < 4; ++r) { const f32x4* xr = (const f32x4*)(x + (size_t)(m0 + r) * DM) + lane;
#pragma unroll
            for (int j = 0; j < 4; ++j) v[r][j] = xr[64 * j]; }
#pragma unroll
        for (int r = 0; r < 4; ++r) { s2[r] = 0.f;
#pragma unroll
            for (int j = 0; j < 4; ++j) s2[r] += (v[r][j][0] * v[r][j][0] + v[r][j][1] * v[r][j][1]) + (v[r][j][2] * v[r][j][2] + v[r][j][3] * v[r][j][3]); }
#pragma unroll
        for (int o = 1; o < 64; o <<= 1) {
#pragma unroll
            for (int r = 0; r < 4; ++r) s2[r] += __shfl_xor(s2[r], o); }
#pragma unroll
        for (int r = 0; r < 4; ++r) { const float rstd = 1.0f / sqrtf(s2[r] * (1.0f / DM) + EPS);
            u32x2* o8 = (u32x2*)(XN + (size_t)(m0 + r) * DM) + lane;
#pragma unroll
            for (int j = 0; j < 4; ++j) { u32x2 w; w.x = pk2(v[r][j][0] * rstd, v[r][j][1] * rstd); w.y = pk2(v[r][j][2] * rstd, v[r][j][3] * rstd); o8[64 * j] = w; } }
    }
    const int gt = bid * 512 + tid, NGT = G * 512;
    { const float* wsf = a.in[5]; bf16* wsm = (bf16*)(ws + WS_WSM);
      for (int e = gt; e < 16 * 128 * 128 / 2; e += NGT) { const int idx = 2 * e, s = idx & 127, t = (idx >> 7) & 127;
          const f32x2 w = *(const f32x2*)(wsf + idx); *(unsigned*)(wsm + idx) = pk2(s <= t ? w[0] : 0.f, (s + 1) <= t ? w[1] : 0.f); } }
    { float* rot = (float*)(ws + WS_ROT);
      for (int e = gt; e < SEQ * 32; e += NGT) { const int pos = e >> 5, i = e & 31;
          float inv = 0.f;
#pragma unroll
          for (int k = 0; k < 32; ++k) if (i == k) inv = a.inv_freq[k];
          const float ang = (float)pos * inv;
          const double rev = (double)ang * 0.15915494309189535; const float fr = (float)(rev - rint(rev));
          f32x2 cs; cs[0] = __builtin_amdgcn_cosf(fr); cs[1] = __builtin_amdgcn_sinf(fr); *(f32x2*)(rot + (size_t)e * 2) = cs; } }
}

typedef short v4i16_t __attribute__((ext_vector_type(4)));
__device__ __forceinline__ s16x4 lds_tr(const LAS bf16* p) { return __builtin_bit_cast(s16x4, __builtin_amdgcn_ds_read_tr16_b64_v4i16((LAS v4i16_t*)p)); }
__device__ __forceinline__ void spatial_phase(LAS unsigned char* lds, const bf16* Z, const float* st1, const bf16* wsm, const float* ln_g, const float* ln_b, const float* bs, bf16* Y, int bid, int G) {
    const int tid = threadIdx.x, lane = tid & 63, wid = tid >> 6, fr = lane & 15, fq = lane >> 4;
    constexpr int VS = 136, VBUF = 128 * VS * 2;
    LAS f32x2* stat = (LAS f32x2*)(lds + 2 * VBUF);
    const int dw = wid & 1, tw = wid >> 1;
    const int nunits = (2048 - bid + G - 1) / G;
    const int g = bid & 15, ch0 = g * 128;
    for (int idx = tid; idx < nunits * 128; idx += 512) {
        const int c = (bid + (idx >> 7) * G) >> 4;
        const f32x4* p = (const f32x4*)(st1 + (size_t)(c * 128 + (idx & 127)) * 64);
        float s = 0.f, q = 0.f;
#pragma unroll
        for (int i = 0; i < 16; ++i) { const f32x4 v = p[i]; s += v[0] + v[2]; q += v[1] + v[3]; }
        const float mean = s * (1.0f / AW), var = q * (1.0f / AW) - mean * mean;
        f32x2 o; o[0] = mean; o[1] = 1.0f / sqrtf(var + EPS); stat[idx] = o;
    }
    bf16x8 Bw[4][2];
#pragma unroll
    for (int ks = 0; ks < 4; ++ks)
#pragma unroll
        for (int n = 0; n < 2; ++n) { Bw[ks][n] = (bf16x8){0, 0, 0, 0, 0, 0, 0, 0};
            if (ks <= tw) Bw[ks][n] = *(const bf16x8*)(wsm + ((size_t)g * 128 + 32 * tw + 16 * n + fr) * 128 + 32 * ks + 8 * fq); }
    const int cg8 = (tid & 15) * 8, ar = (tid >> 4) * 2;
    const f32x4 g0 = *(const f32x4*)(ln_g + ch0 + cg8), g1 = *(const f32x4*)(ln_g + ch0 + cg8 + 4);
    const f32x4 b0 = *(const f32x4*)(ln_b + ch0 + cg8), b1 = *(const f32x4*)(ln_b + ch0 + cg8 + 4);
    float bias[2];
#pragma unroll
    for (int n = 0; n < 2; ++n) bias[n] = bs[g * 128 + 32 * tw + 16 * n + fr];
    u32x4 vr[4];
#define SP_LOADV(i_) do { const int c_ = (bid + (i_) * G) >> 4; const bf16* p_ = Z + (size_t)(c_ * 128 + ar) * NZ + AW + ch0 + cg8; \
        vr[0] = *(const u32x4*)p_; vr[1] = *(const u32x4*)(p_ + NZ); vr[2] = *(const u32x4*)(p_ + (size_t)64 * NZ); vr[3] = *(const u32x4*)(p_ + (size_t)65 * NZ); } while (0)
#define SP_NORM(i_) do { LAS bf16* vb_ = (LAS bf16*)(lds + ((i_) & 1) * VBUF); \
        _Pragma("unroll") for (int r_ = 0; r_ < 4; ++r_) { const int row_ = ar + (r_ & 1) + 64 * (r_ >> 1); const f32x2 st_ = stat[(i_) * 128 + row_]; const u32x4 w_ = vr[r_]; u32x4 o_; \
            _Pragma("unroll") for (int e_ = 0; e_ < 4; ++e_) { const f32x4 gg_ = e_ < 2 ? g0 : g1, bb_ = e_ < 2 ? b0 : b1; \
                const float n0_ = (bflo(w_[e_]) - st_[0]) * st_[1] * gg_[(2 * e_) & 3] + bb_[(2 * e_) & 3], n1_ = (bfhi(w_[e_]) - st_[0]) * st_[1] * gg_[(2 * e_ + 1) & 3] + bb_[(2 * e_ + 1) & 3]; \
                o_[e_] = pk2(n0_, n1_); } \
            *(LAS u32x4*)(vb_ + row_ * VS + cg8) = o_; } } while (0)
    SP_LOADV(0);
    __syncthreads();
    SP_NORM(0);
    __syncthreads();
    for (int i = 0; i < nunits; ++i) {
        const int c = (bid + i * G) >> 4, row0 = c * 128;
        if (i + 1 < nunits) SP_LOADV(i + 1);
        u32x2 ur[2][4], gr[2][4];
#pragma unroll
        for (int n = 0; n < 2; ++n)
#pragma unroll
            for (int m = 0; m < 4; ++m) { const bf16* p = Z + (size_t)(row0 + 32 * tw + 16 * n + fr) * NZ + ch0 + 64 * dw + 16 * m + 4 * fq;
                ur[n][m] = *(const u32x2*)p; gr[n][m] = *(const u32x2*)(p + 2 * AW); }
        f32x4 acc[4][2];
#pragma unroll
        for (int m = 0; m < 4; ++m)
#pragma unroll
            for (int n = 0; n < 2; ++n) acc[m][n] = (f32x4){0.f, 0.f, 0.f, 0.f};
        const LAS bf16* vb = (const LAS bf16*)(lds + (i & 1) * VBUF) + (8 * fq + (fr >> 2)) * VS + 64 * dw + 4 * (fr & 3);
#pragma unroll
        for (int ks = 0; ks < 4; ++ks) if (ks <= tw) {
            bf16x8 A[4];
#pragma unroll
            for (int m = 0; m < 4; ++m) { const s16x4 lo = lds_tr(vb + (32 * ks) * VS + 16 * m), h4 = lds_tr(vb + (32 * ks + 4) * VS + 16 * m);
                A[m] = (bf16x8){lo[0], lo[1], lo[2], lo[3], h4[0], h4[1], h4[2], h4[3]}; }
#pragma unroll
            for (int m = 0; m < 4; ++m)
#pragma unroll
                for (int n = 0; n < 2; ++n) acc[m][n] = __builtin_amdgcn_mfma_f32_16x16x32_bf16(A[m], Bw[ks][n], acc[m][n], 0, 0, 0);
        }
#pragma unroll
        for (int n = 0; n < 2; ++n) { const size_t row = (size_t)(row0 + 32 * tw + 16 * n + fr);
#pragma unroll
            for (int m = 0; m < 4; ++m) { const int col = ch0 + 64 * dw + 16 * m + 4 * fq;
                const u32x2 uu = ur[n][m], gt = gr[n][m];
                const f32x4 sv = acc[m][n] + bias[n];
                const float y0 = bflo(uu.x) * sv[0] * silu(bflo(gt.x)), y1 = bfhi(uu.x) * sv[1] * silu(bfhi(gt.x));
                const float y2 = bflo(uu.y) * sv[2] * silu(bflo(gt.y)), y3 = bfhi(uu.y) * sv[3] * silu(bfhi(gt.y));
                u32x2 w; w.x = pk2(y0, y1); w.y = pk2(y2, y3); *(u32x2*)(Y + row * AW + col) = w; } }
        if (i + 1 < nunits) SP_NORM(i + 1);
        __syncthreads();
    }
#undef SP_LOADV
#undef SP_NORM
}

__device__ __forceinline__ int crow(int r, int hi) { return (r & 3) + 8 * (r >> 2) + 4 * hi; }
__device__ __forceinline__ void attn_phase(LAS unsigned char* lds, const bf16* Q, const bf16* Gt, const bf16* Kb, const bf16* Vb, const float* sinks, bf16* Y2, int bid, int G) {
    const int tid = threadIdx.x, lane = tid & 63, wid = tid >> 6, q31 = lane & 31, hi = lane >> 5;
    constexpr int KS = 72, VS = 264;
    LAS bf16* Ks = (LAS bf16*)lds;
    LAS bf16* Vt = (LAS bf16*)(lds + 256 * KS * 2);
    const float NEG = -INFINITY;
    for (int unit = bid; unit < 256; unit += G) {
        const int kvh = unit & 1, n = (unit >> 1) & 31, b = unit >> 6;
        const int row0 = b * SEQ + n * 128;
#pragma unroll
        for (int k = 0; k < 4; ++k) { const int idx = tid + 512 * k, r = idx >> 3, c8 = (idx & 7) * 8;
            u32x4 v = (u32x4){0u, 0u, 0u, 0u};
            if (n > 0 || r >= 128) v = *(const u32x4*)(Kb + (size_t)(row0 - 128 + r) * 128 + kvh * 64 + c8);
            *(LAS u32x4*)(Ks + r * KS + c8) = v; }
#pragma unroll
        for (int k = 0; k < 2; ++k) { const int it = tid + 512 * k, a2 = (it >> 3) * 2, d8 = (it & 7) * 8;
            u32x4 r0 = (u32x4){0u, 0u, 0u, 0u}, r1 = r0;
            if (n > 0 || a2 >= 128) { const bf16* p = Vb + (size_t)(row0 - 128 + a2) * 128 + kvh * 64 + d8; r0 = *(const u32x4*)p; r1 = *(const u32x4*)(p + 128); }
#pragma unroll
            for (int e = 0; e < 8; ++e) { const unsigned w0 = r0[e >> 1], w1 = r1[e >> 1];
                const unsigned lo = (e & 1) ? (w0 >> 16) : (w0 & 0xffffu), hh = (e & 1) ? (w1 & 0xffff0000u) : (w1 << 16);
                *(LAS unsigned*)(Vt + (d8 + e) * VS + a2) = lo | hh; } }
        __syncthreads();
        const int hq = kvh * 8 + wid; const float sink2 = sinks[hq] * LOG2E;
#pragma unroll 1
        for (int qb = 0; qb < 4; ++qb) {
            const size_t grow = (size_t)(row0 + 32 * qb + q31);
            bf16x8 qf[4];
#pragma unroll
            for (int d0 = 0; d0 < 4; ++d0) qf[d0] = *(const bf16x8*)(Q + grow * 1024 + hq * 64 + 16 * d0 + 8 * hi);
            f32x16 s[5];
#pragma unroll
            for (int i = 0; i < 5; ++i) {
#pragma unroll
                for (int r = 0; r < 16; ++r) s[i][r] = 0.f;
#pragma unroll
                for (int d0 = 0; d0 < 4; ++d0) { const bf16x8 kf = *(const LAS bf16x8*)(Ks + (32 * (qb + i) + q31) * KS + 16 * d0 + 8 * hi);
                    s[i] = __builtin_amdgcn_mfma_f32_32x32x16_bf16(kf, qf[d0], s[i], 0, 0, 0); } }
#pragma unroll
            for (int r = 0; r < 16; ++r) { const int cr = crow(r, hi); if (!(cr > q31)) s[0][r] = NEG; if (cr > q31) s[4][r] = NEG; }
            if (n == 0) {
#pragma unroll
                for (int i = 0; i < 4; ++i) if (qb + i < 4) {
#pragma unroll
                    for (int r = 0; r < 16; ++r) s[i][r] = NEG; } }
            float mx = sink2;
#pragma unroll
            for (int i = 0; i < 5; ++i)
#pragma unroll
                for (int r = 0; r < 16; ++r) mx = fmaxf(mx, s[i][r]);
            mx = fmaxf(mx, __shfl_xor(mx, 32));
            float sum = 0.f;
#pragma unroll
            for (int i = 0; i < 5; ++i)
#pragma unroll
                for (int r = 0; r < 16; ++r) { const float p = __builtin_amdgcn_exp2f(s[i][r] - mx); s[i][r] = p; sum += p; }
            sum += __shfl_xor(sum, 32);
            const float inv = 1.0f / (sum + __builtin_amdgcn_exp2f(sink2 - mx));
            f32x16 o[2];
#pragma unroll
            for (int r = 0; r < 16; ++r) { o[0][r] = 0.f; o[1][r] = 0.f; }
#pragma unroll
            for (int i = 0; i < 5; ++i)
#pragma unroll
                for (int sl = 0; sl < 2; ++sl) {
                    u32x4 pw; pw.x = pk2(s[i][8 * sl + 0], s[i][8 * sl + 1]); pw.y = pk2(s[i][8 * sl + 2], s[i][8 * sl + 3]); pw.z = pk2(s[i][8 * sl + 4], s[i][8 * sl + 5]); pw.w = pk2(s[i][8 * sl + 6], s[i][8 * sl + 7]);
                    const bf16x8 pf = __builtin_bit_cast(bf16x8, pw);
#pragma unroll
                    for (int dh = 0; dh < 2; ++dh) { const LAS bf16* vb = Vt + (32 * dh + q31) * VS + 32 * (qb + i) + 16 * sl + 4 * hi;
                        const s16x4 lo = *(const LAS s16x4*)vb, h4 = *(const LAS s16x4*)(vb + 8);
                        const bf16x8 vf = (bf16x8){lo[0], lo[1], lo[2], lo[3], h4[0], h4[1], h4[2], h4[3]};
                        o[dh] = __builtin_amdgcn_mfma_f32_32x32x16_bf16(vf, pf, o[dh], 0, 0, 0); } }
#pragma unroll
            for (int dh = 0; dh < 2; ++dh)
#pragma unroll
                for (int rg = 0; rg < 4; ++rg) { const size_t off = grow * 1024 + hq * 64 + 32 * dh + 8 * rg + 4 * hi;
                    const u32x2 gt = *(const u32x2*)(Gt + off);
                    const float y0 = o[dh][4 * rg + 0] * inv * silu(bflo(gt.x)), y1 = o[dh][4 * rg + 1] * inv * silu(bfhi(gt.x));
                    const float y2 = o[dh][4 * rg + 2] * inv * silu(bflo(gt.y)), y3 = o[dh][4 * rg + 3] * inv * silu(bfhi(gt.y));
                    u32x2 w; w.x = pk2(y0, y1); w.y = pk2(y2, y3); *(u32x2*)(Y2 + off) = w; }
        }
        __syncthreads();
    }
}

__global__ void __launch_bounds__(512, 2) yoco_fwd(Args a) {
    extern __shared__ __attribute__((aligned(16))) unsigned char lds_raw[];
    LAS unsigned char* lds = (LAS unsigned char*)lds_raw;
    const int bid = blockIdx.x, G = gridDim.x;
    unsigned char* ws = a.ws;
    volatile LAS unsigned* MISC = (volatile LAS unsigned*)(lds + 131072);
    if (threadIdx.x < 4) MISC[threadIdx.x] = 0u;
    __syncthreads();
    XcdBarrier bar = xcd_barrier_post((unsigned*)ws, MISC);
    if (a.mask == 0x40000000) { cg::grid_group grid = cg::this_grid(); grid.sync(); }
    float* OUT = a.alt ? (float*)(ws + WS_Q) : a.out;
    bf16* Ybuf = (bf16*)OUT;

    if (a.mask & 1) p0_prologue(a, lds, bid, G);
    if (a.mask & 256) xcd_barrier(bar);

    if (a.mask & 2) {
        pg8::Gemm g{(const bf16*)(ws + WS_XN), (const bf16*)(ws + WS_WIN), M, NZ, DM}; pg8::StaticOrder S; S.init(M, NZ, G, bid);
        pg8::EpiZ E{(bf16*)(ws + WS_Z), (float*)(ws + WS_ST1)};
        pg8::gemm_phase<pg8::EpiZ, pg8::StaticOrder, true, true>(lds, g, S, E);
    }
    if (a.mask & 256) xcd_barrier(bar);

    if (a.mask & 4) spatial_phase(lds, (const bf16*)(ws + WS_Z), (const float*)(ws + WS_ST1), (const bf16*)(ws + WS_WSM), a.in[3], a.in[4], a.in[6], Ybuf, bid, G);
    if (a.mask & 256) xcd_barrier(bar);

    if (a.mask & 8) {
        pg8::Gemm g{Ybuf, (const bf16*)(ws + WS_WOA), M, DM, AW}; pg8::StaticOrder S; S.init(M, DM, G, bid);
        pg8::EpiRes E{a.in[0], (float*)(ws + WS_H), (bf16*)(ws + WS_HB), (float*)(ws + WS_ST2)};
        pg8::gemm_phase<pg8::EpiRes, pg8::StaticOrder, true, true>(lds, g, S, E);
    }
    if (a.mask & 256) xcd_barrier(bar);

    if (a.mask & 16) {
        pg8::Gemm g{(const bf16*)(ws + WS_HB), (const bf16*)(ws + WS_WCAT), M, NQKV, DM}; pg8::StaticOrder S; S.init(M, NQKV, G, bid);
        pg8::EpiQKV E{(const float*)(ws + WS_ST2), (const float*)(ws + WS_ROT), a.in[13], a.in[10], (bf16*)(ws + WS_Q), (bf16*)(ws + WS_G), (bf16*)(ws + WS_K), (bf16*)(ws + WS_V)};
        pg8::gemm_phase<pg8::EpiQKV, pg8::StaticOrder, true, true>(lds, g, S, E);
    }
    if (a.mask & 256) xcd_barrier(bar);

    if (a.mask & 32) attn_phase(lds, (const bf16*)(ws + WS_Q), (const bf16*)(ws + WS_G), (const bf16*)(ws + WS_K), (const bf16*)(ws + WS_V), a.in[14], (bf16*)(ws + WS_Y2), bid, G);
    if (a.mask & 256) xcd_barrier(bar);

    if (a.mask & 64) {
        pg8::Gemm g{(const bf16*)(ws + WS_Y2), (const bf16*)(ws + WS_WOB), M, DM, DM}; pg8::StaticOrder S; S.init(M, DM, G, bid);
        pg8::EpiRes E{(const float*)(ws + WS_H), OUT, nullptr, (float*)(ws + WS_ST3)};
        pg8::gemm_phase<pg8::EpiRes, pg8::StaticOrder, true, true>(lds, g, S, E);
    }
    if (a.mask & 256) xcd_barrier(bar);

    if (a.mask & 128) {
        const int lane = threadIdx.x & 63, gw = bid * 8 + (threadIdx.x >> 6), NGW = G * 8;
        const float* st3 = (const float*)(ws + WS_ST3); const f32x4* gp = (const f32x4*)a.in[16] + lane;
        f32x4 gv[4];
#pragma unroll
        for (int j = 0; j < 4; ++j) gv[j] = gp[64 * j];
        for (int m = gw; m < M; m += NGW) {
            const f32x4* p = (const f32x4*)(st3 + (size_t)m * 16); const f32x4 s4 = (p[0] + p[1]) + (p[2] + p[3]);
            const float rstd = 1.0f / sqrtf(((s4[0] + s4[1]) + (s4[2] + s4[3])) * (1.0f / DM) + EPS);
            const f32x4* xr = (const f32x4*)(a.out + (size_t)m * DM) + lane; f32x4* xo = (f32x4*)(OUT + (size_t)m * DM) + lane;
#pragma unroll
            for (int j = 0; j < 4; ++j) xo[64 * j] = xr[64 * j] * rstd * gv[j];
        }
    }
}

extern "C" void kernel_launch(void* const* d_in, const int* in_sizes, int n_in, void* d_out, int out_size, void* d_ws, size_t ws_size, hipStream_t stream) {
    static int grid = 0;
    if (grid == 0) {
        if (n_in != 17 || in_sizes[0] != M * DM || out_size != M * DM || ws_size < WS_END) { fprintf(stderr, "kernel_launch: unexpected shapes (n_in %d, in0 %d, out %d, ws %zu)\n", n_in, n_in > 0 ? in_sizes[0] : -1, out_size, ws_size); grid = -1; return; }
        int dev = 0, cus = 0, per_cu = 0;
        hipGetDevice(&dev); hipDeviceGetAttribute(&cus, hipDeviceAttributeMultiprocessorCount, dev);
        hipFuncSetAttribute((const void*)yoco_fwd, hipFuncAttributeMaxDynamicSharedMemorySize, LDS_BYTES);
        hipOccupancyMaxActiveBlocksPerMultiprocessor(&per_cu, (const void*)yoco_fwd, 512, LDS_BYTES);
        (void)hipGetLastError();
        if (per_cu < 1) per_cu = 1;
        grid = cus * 1;
        if (grid <= 0) grid = 256;
    }
    if (grid < 0) return;
    Args a{};
    for (int i = 0; i < 17; ++i) a.in[i] = (const float*)d_in[i];
    a.out = (float*)d_out; a.ws = (unsigned char*)d_ws;
    for (int i = 0; i < 32; ++i) a.inv_freq[i] = powf(10000.0f, -(float)(2 * i) / 64.0f);
    a.mask = 0x1ff; a.alt = 0;
    (void)hipMemsetAsync(d_ws, 0, 16384, stream);
    void* args[] = {&a};
    hipError_t e = hipLaunchCooperativeKernel((const void*)yoco_fwd, dim3(grid), dim3(512), args, LDS_BYTES, stream);
    if (e != hipSuccess) fprintf(stderr, "cooperative launch failed: %s (grid %d)\n", hipGetErrorString(e), grid);
#ifdef PROBE_MASK
    a.mask = PROBE_MASK; a.alt = 1;
    (void)hipMemsetAsync(d_ws, 0, 16384, stream);
    e = hipLaunchCooperativeKernel((const void*)yoco_fwd, dim3(grid), dim3(512), args, LDS_BYTES, stream);
#endif
}
```
